# Optimizing an MI355X kernel written in HIP

```python
import jax, jax.numpy as jnp
from jax import lax
import numpy as np

D_MODEL = 2048
BATCH = 2
SEQ = 4096
DEPTH = 1

CHUNK = 64
QBLOCK = 128
FOX_HEADS = 16
FOX_HEAD_DIM = 64
FOX_WIDTH = FOX_HEADS * FOX_HEAD_DIM
MLA_HEADS = 8
MLA_NOPE_DIM = 128
MLA_ROPE_DIM = 64
MLA_V_DIM = 128
MLA_Q_LORA = 512
MLA_KV_LORA = 256
MLA_QK_DIM = MLA_NOPE_DIM + MLA_ROPE_DIM
MLA_WIDTH = MLA_HEADS * MLA_V_DIM
ROPE_THETA = 10000.0
D_FF = 4 * D_MODEL
LN_EPS = 1e-5
RMS_EPS = 1e-6
N_ADA = 6
IN_SPLITS = (3 * FOX_WIDTH, FOX_HEADS, MLA_Q_LORA, MLA_KV_LORA, MLA_ROPE_DIM, D_MODEL, D_MODEL)
D_IN = sum(IN_SPLITS)

kernel_name = 'hybrid_fox_mla_sqrelu_block'


def layer_norm(x, g, b):
    xf = x.astype(jnp.float32)
    mu = jnp.mean(xf, axis=-1, keepdims=True)
    var = jnp.mean(jnp.square(xf - mu), axis=-1, keepdims=True)
    y = (xf - mu) * lax.rsqrt(var + LN_EPS)
    return (y * g + b).astype(x.dtype)


def rms_norm(x, g):
    xf = x.astype(jnp.float32)
    y = xf * lax.rsqrt(jnp.mean(jnp.square(xf), axis=-1, keepdims=True) + RMS_EPS)
    return (y * g).astype(x.dtype)


def rope_tables(seq_len):
    pos = jnp.arange(seq_len, dtype=jnp.float32)
    inv_freq = ROPE_THETA ** (-jnp.arange(0, MLA_ROPE_DIM, 2, dtype=jnp.float32) / MLA_ROPE_DIM)
    ang = pos[:, None] * inv_freq[None, :]
    return jnp.cos(ang), jnp.sin(ang)


def apply_rope(x, cos, sin):
    half = x.shape[-1] // 2
    x1, x2 = x[..., :half], x[..., half:]
    cos = cos.astype(x.dtype)
    sin = sin.astype(x.dtype)
    return jnp.concatenate([x1 * cos - x2 * sin, x1 * sin + x2 * cos], axis=-1)


def to_blocks(t):
    b, s = t.shape[0], t.shape[1]
    return t.reshape(b, s // QBLOCK, QBLOCK, *t.shape[2:]).swapaxes(0, 1)


def from_blocks(t):
    t = t.swapaxes(0, 1)
    return t.reshape(t.shape[0], t.shape[1] * t.shape[2], *t.shape[3:])


def fox_attention(q, k, v, log_f):
    b, s, h, dh = q.shape
    nb = s // QBLOCK
    scale = dh ** -0.5
    cum = jnp.cumsum(log_f, axis=1)
    cum_k = cum.transpose(0, 2, 1)
    k_pos = jnp.arange(s)

    def one_block(args):
        i, q_i, c_i = args
        logits = jnp.einsum('bqhd,bkhd->bhqk', q_i, k, preferred_element_type=jnp.float32) * scale
        logits = logits + (c_i.transpose(0, 2, 1)[..., :, None] - cum_k[..., None, :])
        q_pos = i * QBLOCK + jnp.arange(QBLOCK)
        mask = k_pos[None, :] <= q_pos[:, None]
        logits = jnp.where(mask, logits, -jnp.inf)
        p = jax.nn.softmax(logits, axis=-1).astype(v.dtype)
        return jnp.einsum('bhqk,bkhd->bqhd', p, v)

    out = lax.map(one_block, (jnp.arange(nb), to_blocks(q), to_blocks(cum)))
    return from_blocks(out)


def mla_attention(q_nope, q_rope, k_nope, k_rope, v):
    b, s, h, _ = q_nope.shape
    nb = s // QBLOCK
    scale = MLA_QK_DIM ** -0.5
    k_chunk = jnp.arange(s) // CHUNK

    def one_block(args):
        i, qn, qr = args
        logits = (jnp.einsum('bqhd,bkhd->bhqk', qn, k_nope, preferred_element_type=jnp.float32)
                  + jnp.einsum('bqhr,bkr->bhqk', qr, k_rope, preferred_element_type=jnp.float32)) * scale
        q_chunk = (i * QBLOCK + jnp.arange(QBLOCK)) // CHUNK
        mask = k_chunk[None, :] <= q_chunk[:, None]
        logits = jnp.where(mask, logits, -jnp.inf)
        p = jax.nn.softmax(logits, axis=-1).astype(v.dtype)
        return jnp.einsum('bhqk,bkhd->bqhd', p, v)

    out = lax.map(one_block, (jnp.arange(nb), to_blocks(q_nope), to_blocks(q_rope)))
    return from_blocks(out)


def token_mixers(u, w_in, b_forget, g_q_norm, w_q_up, g_kv_norm, w_kv_up, w_branch_fox, w_branch_mla, w_out):
    b, s, _ = u.shape
    proj = u @ w_in
    cuts = [int(v) for v in np.cumsum(IN_SPLITS)[:-1]]
    qkv, f_logit, c_q, c_kv, k_rope, g_fox, g_mla = jnp.split(proj, cuts, axis=-1)

    qkv = qkv.reshape(b, s, 3, FOX_HEADS, FOX_HEAD_DIM)
    log_f = jax.nn.log_sigmoid(f_logit.astype(jnp.float32) + b_forget.astype(jnp.float32))
    y_fox = fox_attention(qkv[:, :, 0], qkv[:, :, 1], qkv[:, :, 2], log_f).reshape(b, s, FOX_WIDTH)

    q = (rms_norm(c_q, g_q_norm) @ w_q_up).reshape(b, s, MLA_HEADS, MLA_QK_DIM)
    kv = (rms_norm(c_kv, g_kv_norm) @ w_kv_up).reshape(b, s, MLA_HEADS, MLA_NOPE_DIM + MLA_V_DIM)
    cos, sin = rope_tables(s)
    q_nope = q[..., :MLA_NOPE_DIM]
    q_rope = apply_rope(q[..., MLA_NOPE_DIM:], cos[:, None, :], sin[:, None, :])
    k_rope = apply_rope(k_rope, cos, sin)
    k_nope = kv[..., :MLA_NOPE_DIM]
    v = kv[..., MLA_NOPE_DIM:]
    y_mla = mla_attention(q_nope, q_rope, k_nope, k_rope, v).reshape(b, s, MLA_WIDTH)

    merged = jax.nn.sigmoid(g_fox) * (y_fox @ w_branch_fox) + jax.nn.sigmoid(g_mla) * (y_mla @ w_branch_mla)
    return merged @ w_out


def setup_inputs(seed: int = 0) -> dict:
    key = jax.random.key(seed)
    ks = jax.random.split(key, 24)
    beta = (8.0 * DEPTH) ** -0.25
    f32 = jnp.float32

    def nrm(k, shape, fan_in, mult=1.0):
        return jax.random.normal(k, shape, f32) * (fan_in ** -0.5) * mult

    def gain(k, shape):
        return 1.0 + 0.02 * jax.random.normal(k, shape, f32)

    def bias(k, shape):
        return 0.02 * jax.random.normal(k, shape, f32)

    return {
        'x': jax.random.normal(ks[0], (BATCH, SEQ, D_MODEL), f32),
        'c': jax.random.normal(ks[1], (BATCH, D_MODEL), f32),
        'w_ada': nrm(ks[2], (DEPTH, D_MODEL, N_ADA * D_MODEL), D_MODEL),
        'b_ada': bias(ks[3], (DEPTH, N_ADA * D_MODEL)),
        'w_in': nrm(ks[4], (DEPTH, D_MODEL, D_IN), D_MODEL),
        'b_forget': jax.random.uniform(ks[5], (DEPTH, FOX_HEADS), f32, minval=1.0, maxval=5.0),
        'g_q_norm': gain(ks[6], (DEPTH, MLA_Q_LORA)),
        'w_q_up': nrm(ks[7], (DEPTH, MLA_Q_LORA, MLA_HEADS * MLA_QK_DIM), MLA_Q_LORA),
        'g_kv_norm': gain(ks[8], (DEPTH, MLA_KV_LORA)),
        'w_kv_up': nrm(ks[9], (DEPTH, MLA_KV_LORA, MLA_HEADS * (MLA_NOPE_DIM + MLA_V_DIM)), MLA_KV_LORA),
        'w_branch_fox': nrm(ks[10], (DEPTH, FOX_WIDTH, D_MODEL), FOX_WIDTH),
        'w_branch_mla': nrm(ks[11], (DEPTH, MLA_WIDTH, D_MODEL), MLA_WIDTH),
        'w_out': nrm(ks[12], (DEPTH, D_MODEL, D_MODEL), D_MODEL, beta),
        'ln1_g': gain(ks[13], (DEPTH, D_MODEL)),
        'ln1_b': bias(ks[14], (DEPTH, D_MODEL)),
        'w_mlp_up': nrm(ks[15], (DEPTH, D_MODEL, D_FF), D_MODEL),
        'w_mlp_down': nrm(ks[16], (DEPTH, D_FF, D_MODEL), D_FF, beta),
        'ln2_g': gain(ks[17], (DEPTH, D_MODEL)),
        'ln2_b': bias(ks[18], (DEPTH, D_MODEL)),
    }


def reference(x, c, w_ada, b_ada, w_in, b_forget, g_q_norm, w_q_up, g_kv_norm, w_kv_up,
              w_branch_fox, w_branch_mla, w_out, ln1_g, ln1_b, w_mlp_up, w_mlp_down, ln2_g, ln2_b):
    alpha = (2.0 * DEPTH) ** 0.25
    for l in range(DEPTH):
        mod = jax.nn.silu(c) @ w_ada[l] + b_ada[l]
        shift1, scale1, gate1, shift2, scale2, gate2 = jnp.split(mod[:, None, :], N_ADA, axis=-1)

        u = x * (1.0 + scale1) + shift1
        mix = token_mixers(u, w_in[l], b_forget[l], g_q_norm[l], w_q_up[l], g_kv_norm[l], w_kv_up[l],
                           w_branch_fox[l], w_branch_mla[l], w_out[l])
        x = layer_norm(alpha * x + gate1 * mix, ln1_g[l], ln1_b[l])

        u2 = x * (1.0 + scale2) + shift2
        h = jnp.square(jax.nn.relu(u2 @ w_mlp_up[l])) @ w_mlp_down[l]
        x = layer_norm(alpha * x + gate2 * h, ln2_g[l], ln2_b[l])
    return x
```

```cpp
#include <hip/hip_runtime.h>
#include <hip/hip_cooperative_groups.h>
#include <cstdio>
#include <cstdint>
namespace cg = cooperative_groups;

#ifndef MK_N_LAUNCHES
#define PROBE_DUP (-1)
#define MK_N_LAUNCHES 1
#endif

#define LAS __attribute__((address_space(3)))
typedef unsigned short bf16_t;
typedef short bf16x8 __attribute__((ext_vector_type(8)));
typedef short s16x4 __attribute__((ext_vector_type(4)));
typedef float f32x4 __attribute__((ext_vector_type(4)));
typedef float f32x16 __attribute__((ext_vector_type(16)));
typedef unsigned u32x4 __attribute__((ext_vector_type(4)));
typedef unsigned u32x2 __attribute__((ext_vector_type(2)));
typedef float f32x2v __attribute__((ext_vector_type(2)));

constexpr int SEQ = 4096, DMODEL = 2048, MTOK = 8192, DIN = 8016, NPROJ = 8192, DFF = 8192, NADA = 12288;
constexpr int QW = 1536, KVW = 2048;
constexpr float LN_EPS = 1e-5f, RMS_EPS = 1e-6f;
constexpr float LOG2E = 1.4426950408889634f;
constexpr float ALPHA = 1.189207115002721f;
constexpr float C2F = 0.125f * LOG2E;
constexpr float QSC = 0.07216878364870322f * LOG2E;
constexpr int PC_Q = 0, PC_K = 1024, PC_V = 2048, PC_CQ = 3072, PC_CKV = 3584, PC_F = 3840, PC_KR = 3904, PC_GF = 4096, PC_GM = 6144;
constexpr int KC_ADA = 32;

constexpr size_t MiB = 1u << 20;
constexpr size_t WS_CTL = 0, WS_MOD = 1 * MiB, WS_PART = 340 * MiB, WS_TOT = 2 * MiB, WS_NCUM = 3 * MiB, WS_CUM = 4 * MiB, WS_RSTD = 4 * MiB + 512 * 1024, WS_ROPE = 5 * MiB, WS_KROPE = 6 * MiB;
constexpr size_t WS_WIN = 8 * MiB, WS_WUP = 40 * MiB, WS_WDN = 72 * MiB, WS_WOUT = 104 * MiB, WS_WBR = 112 * MiB, WS_WQ = 120 * MiB, WS_WKV = 122 * MiB;
constexpr size_t WS_PROJ = 124 * MiB;
constexpr size_t WS_U = 252 * MiB;
constexpr size_t WS_QMLA = 284 * MiB, WS_KVMLA = 308 * MiB;
constexpr size_t WS_MERGED = 284 * MiB;
constexpr size_t WS_END = 344 * MiB;

constexpr int LDS_BYTES = 147456;

__device__ __forceinline__ unsigned f2bf(float f) { unsigned u = __builtin_bit_cast(unsigned, f); return (u + 0x7fffu + ((u >> 16) & 1u)) >> 16; }
__device__ __forceinline__ unsigned pk2(float lo, float hi) { return f2bf(lo) | (f2bf(hi) << 16); }
__device__ __forceinline__ float bf2f(unsigned short b) { return __builtin_bit_cast(float, (unsigned)b << 16); }
__device__ __forceinline__ float bflo(unsigned w) { return __builtin_bit_cast(float, w << 16); }
__device__ __forceinline__ float bfhi(unsigned w) { return __builtin_bit_cast(float, w & 0xffff0000u); }
__device__ __forceinline__ float wave_sum(float v) {
#pragma unroll
    for (int o = 1; o < 64; o <<= 1) v += __shfl_xor(v, o);
    return v;
}
__device__ __forceinline__ float sigmoidf_(float x) { return __builtin_amdgcn_rcpf(1.0f + __builtin_amdgcn_exp2f(-1.4426950408889634f * x)); }

namespace pg8 {
constexpr int BM = 256, BK = 64, HALF = 128, HTB = HALF * BK * 2, STAGE_BYTES = 8 * HTB, NXCD = 8, WGM = 4;
__host__ __device__ __forceinline__ int lds_byte(int r, int c) { const int st = (r >> 4) * 2 + (c >> 5), rr = r & 15, cc = c & 31, ob = rr * 64 + cc * 2; return st * 1024 + (ob ^ (((ob >> 9) & 1) << 5)); }
__host__ __device__ __forceinline__ void stage_rc(int b, int& R, int& C) { const int st = b / 1024, sb = b % 1024, swz = sb ^ (((sb >> 9) & 1) << 5); R = (st >> 1) * 16 + swz / 64; C = (st & 1) * 32 + (swz % 64) / 2; }
__host__ __device__ __forceinline__ int perm32(int rho) { const int n = rho >> 4, i = rho & 15; return 8 * (i >> 2) + 4 * n + (i & 3); }

struct Unit { int pm, pn, pb, sel; long aoff; };
struct Gemm { const bf16_t* A; const bf16_t* Bt; int M, N, K, lda; };

__host__ __device__ __forceinline__ void map_tile(int wgid, int nM, int nN, int nwg, int& pm, int& pn) {
    { const int q = nwg / NXCD, r = nwg % NXCD, xcd = wgid % NXCD, off = wgid / NXCD; wgid = (xcd < r ? xcd * (q + 1) : r * (q + 1) + (xcd - r) * q) + off; }
    const int wgm = (nN >= 16) ? WGM : WGM / 2;
    const int nig = wgm * nN, gid = wgid / nig, fm = gid * wgm, gsz = (nM - fm) < wgm ? (nM - fm) : wgm;
    pm = fm + ((wgid % nig) % gsz); pn = (wgid % nig) / gsz;
}
struct StaticOrder {
    int nM, nN, nwg, G, c;
    __device__ void init(int M, int N, int G_, int c_) { nM = M / BM; nN = N / BM; nwg = nM * nN; G = G_; c = c_; }
    __device__ bool next(int i, Unit& u) const {
        const long L = (long)i * G + c; if (L >= nwg) return false;
        map_tile((int)L, nM, nN, nwg, u.pm, u.pn); u.pb = u.pn; u.sel = 0; u.aoff = 0; return true;
    }
};
struct BranchOrder {
    int nM, nN, nwg, G, c;
    __device__ void init(int M, int N, int G_, int c_) { nM = M / BM; nN = N / BM; nwg = nM * nN; G = G_; c = c_; }
    __device__ bool next(int i, Unit& u) const {
        const long L = (long)(i >> 1) * G + c; if (L >= nwg) return false;
        map_tile((int)L, nM, nN, nwg, u.pm, u.pn); u.sel = i & 1; u.pb = u.pn + u.sel * nN; u.aoff = (long)u.sel * 1024 * 2; return true;
    }
};

__device__ __forceinline__ unsigned cvt_pk_bf16(float lo, float hi) { unsigned r; asm volatile("v_cvt_pk_bf16_f32 %0, %1, %2" : "=v"(r) : "v"(lo), "v"(hi)); return r; }

template <class Epi, class Sched, bool ALIGN_EPI = true>
__device__ __forceinline__ void gemm_phase(LAS unsigned char* lds, const Gemm g, const Sched& S, const Epi& E) {
    const int tid = threadIdx.x, wid = __builtin_amdgcn_readfirstlane(tid >> 6), lane = tid & 63, wr = wid >> 2, wc = wid & 3, fr = lane & 15, fq = lane >> 4;
    const int K = g.K, nt = K / BK, lda = g.lda;
    unsigned voffA[2], voffB[2];
#pragma unroll
    for (int i = 0; i < 2; ++i) { int R, C; stage_rc(tid * 16 + i * 8192, R, C); const int Rb = Epi::PERM ? ((R & ~31) + perm32(R & 31)) : R;
        voffA[i] = (unsigned)(R * lda + C) * 2u; voffB[i] = (unsigned)(Rb * K + C) * 2u; }
    const size_t kstep = (size_t)(BK * 2);
    const size_t hsA = (size_t)HALF * lda * 2, hsB = (size_t)HALF * K * 2;
    const size_t tsA = 2 * hsA, tsB = 2 * hsB;
    const unsigned ldsw = (unsigned)wid * 1024u;
    const int aoff = lds_byte(wr * 64 + fr, fq * 8), boff = lds_byte(wc * 32 + fr, fq * 8);
#define PG8_SA(b, h) (((b) * 2 + (h)) * HTB)
#define PG8_SB(b, h) ((4 + (b) * 2 + (h)) * HTB)
#define PG8_STAGE(bufoff, gbase, voff) do { _Pragma("unroll") for (int _i = 0; _i < 2; ++_i) \
        __builtin_amdgcn_global_load_lds((const unsigned*)((const char*)(gbase) + (voff)[_i]), (LAS unsigned*)(lds + (bufoff) + ldsw + _i * 8192), 16, 0, 0); } while (0)
#define PG8_LDA(dst, b, h) do { _Pragma("unroll") for (int m = 0; m < 4; ++m) _Pragma("unroll") for (int k = 0; k < 2; ++k) dst[m][k] = *(const LAS bf16x8*)(lds + PG8_SA(b, h) + aoff + m * 2048 + k * 1024); } while (0)
#define PG8_LDB(dst, b, h) do { _Pragma("unroll") for (int n = 0; n < 2; ++n) _Pragma("unroll") for (int k = 0; k < 2; ++k) dst[n][k] = *(const LAS bf16x8*)(lds + PG8_SB(b, h) + boff + n * 2048 + k * 1024); } while (0)
#define PG8_MMA(ai, bj, At, Bt) do { __builtin_amdgcn_s_setprio(1); _Pragma("unroll") for (int m = 0; m < 4; ++m) _Pragma("unroll") for (int n = 0; n < 2; ++n) _Pragma("unroll") for (int k = 0; k < 2; ++k) \
        acc[ai][bj][m][n] = __builtin_amdgcn_mfma_f32_16x16x32_bf16(Bt[n][k], At[m][k], acc[ai][bj][m][n], 0, 0, 0); __builtin_amdgcn_s_setprio(0); } while (0)
#define PG8_WAIT_V(n) asm volatile("s_waitcnt vmcnt(" #n ")" ::: "memory")
#define PG8_WAIT_L(n) asm volatile("s_waitcnt lgkmcnt(" #n ")" ::: "memory")
#define PG8_BAR __builtin_amdgcn_s_barrier()
#define PG8_SCHED __builtin_amdgcn_sched_barrier(0)
    Unit cur, nxt; int ui = 0;
    if (!S.next(0, cur)) return;
    f32x4 acc[2][2][4][2];
#pragma unroll
    for (int a = 0; a < 2; ++a)
#pragma unroll
        for (int b = 0; b < 2; ++b)
#pragma unroll
            for (int m = 0; m < 4; ++m)
#pragma unroll
                for (int n = 0; n < 2; ++n) acc[a][b][m][n] = (f32x4){0.f, 0.f, 0.f, 0.f};
    bf16x8 At[4][2], B0[2][2], B1[2][2];
    const char* cA = (const char*)g.A + (size_t)cur.pm * tsA + cur.aoff; const char* cB = (const char*)g.Bt + (size_t)cur.pb * tsB;
    PG8_STAGE(PG8_SB(0, 0), cB, voffB); PG8_STAGE(PG8_SB(0, 1), cB + hsB, voffB); PG8_STAGE(PG8_SA(0, 0), cA, voffA); PG8_STAGE(PG8_SA(0, 1), cA + hsA, voffA);
    if (wr == 1) PG8_BAR;
    PG8_WAIT_V(2); PG8_BAR;
    PG8_STAGE(PG8_SB(1, 0), cB + kstep, voffB); PG8_STAGE(PG8_SA(1, 0), cA + kstep, voffA); PG8_STAGE(PG8_SB(1, 1), cB + hsB + kstep, voffB);
    PG8_WAIT_V(6); PG8_BAR;
    for (;;) {
        const bool has_next = S.next(ui + 1, nxt);
        const char* nA = has_next ? (const char*)g.A + (size_t)nxt.pm * tsA + nxt.aoff : cA; const char* nB = has_next ? (const char*)g.Bt + (size_t)nxt.pb * tsB : cB;
        for (int t = 0; t < nt; t += 2) {
            const bool last = (t == nt - 2);
            const char* a1 = cA + (size_t)(t + 1) * kstep;
            const char* a2 = last ? nA : cA + (size_t)(t + 2) * kstep; const char* b2 = last ? nB : cB + (size_t)(t + 2) * kstep;
            const char* a3 = a2 + kstep; const char* b3 = b2 + kstep;
            PG8_LDB(B0, 0, 0); PG8_LDB(B1, 0, 1); PG8_SCHED; PG8_LDA(At, 0, 0); PG8_STAGE(PG8_SA(1, 1), a1 + hsA, voffA);
            PG8_WAIT_V(8); PG8_WAIT_L(0); PG8_BAR; PG8_MMA(0, 0, At, B0); PG8_MMA(0, 1, At, B1); PG8_BAR; PG8_SCHED;
            PG8_LDA(At, 0, 1); PG8_STAGE(PG8_SB(0, 0), b2, voffB); PG8_STAGE(PG8_SB(0, 1), b2 + hsB, voffB); PG8_STAGE(PG8_SA(0, 0), a2, voffA);
            PG8_WAIT_V(8); PG8_WAIT_L(0); PG8_BAR; PG8_MMA(1, 0, At, B0); PG8_MMA(1, 1, At, B1); PG8_BAR; PG8_SCHED;
            PG8_LDB(B0, 1, 0); PG8_LDB(B1, 1, 1); PG8_SCHED; PG8_LDA(At, 1, 0); PG8_STAGE(PG8_SA(0, 1), a2 + hsA, voffA);
            PG8_WAIT_V(8); PG8_WAIT_L(0); PG8_BAR; PG8_MMA(0, 0, At, B0); PG8_MMA(0, 1, At, B1); PG8_BAR; PG8_SCHED;
            PG8_LDA(At, 1, 1); PG8_STAGE(PG8_SB(1, 0), b3, voffB); PG8_STAGE(PG8_SB(1, 1), b3 + hsB, voffB); PG8_STAGE(PG8_SA(1, 0), a3, voffA);
            PG8_WAIT_V(8); PG8_WAIT_L(0); PG8_BAR; PG8_MMA(1, 0, At, B0); PG8_MMA(1, 1, At, B1); PG8_BAR; PG8_SCHED;
        }
        if constexpr (ALIGN_EPI) { if (wr == 0) PG8_BAR; }
        E(acc, cur, wr, wc, fr, fq);
        if (!has_next) break;
#pragma unroll
        for (int a = 0; a < 2; ++a)
#pragma unroll
            for (int b = 0; b < 2; ++b)
#pragma unroll
                for (int m = 0; m < 4; ++m)
#pragma unroll
                    for (int n = 0; n < 2; ++n) acc[a][b][m][n] = (f32x4){0.f, 0.f, 0.f, 0.f};
        cur = nxt; cA = nA; cB = nB; ++ui;
        if constexpr (ALIGN_EPI) { if (wr == 1) PG8_BAR; }
    }
    PG8_WAIT_V(0);
    if constexpr (!ALIGN_EPI) { if (wr == 0) PG8_BAR; }
    PG8_BAR;
#undef PG8_SA
#undef PG8_SB
#undef PG8_STAGE
#undef PG8_LDA
#undef PG8_LDB
#undef PG8_MMA
#undef PG8_WAIT_V
#undef PG8_WAIT_L
#undef PG8_BAR
#undef PG8_SCHED
}

typedef f32x4 Acc[2][2][4][2];

__device__ __forceinline__ u32x4 pack8(f32x4 v0, f32x4 v1) { u32x4 w; w.x = cvt_pk_bf16(v0[0], v0[1]); w.y = cvt_pk_bf16(v0[2], v0[3]); w.z = cvt_pk_bf16(v1[0], v1[1]); w.w = cvt_pk_bf16(v1[2], v1[3]); return w; }

template <int MODE> struct EpiBf16 {
    static constexpr bool PERM = true;
    bf16_t* O; int ldc; int nscale; float sc0; const float* rowscale;
    __device__ __forceinline__ void operator()(const Acc& acc, const Unit& u, int wr, int wc, int fr, int fq) const {
        const int row0 = u.pm * BM + wr * 64 + fr, col0 = u.pn * BM + wc * 32 + 8 * fq;
        const float sc = (u.pn < nscale) ? sc0 : 1.f;
        float rsv[2][4];
#pragma unroll
        for (int ai = 0; ai < 2; ++ai)
#pragma unroll
            for (int m = 0; m < 4; ++m) rsv[ai][m] = rowscale ? rowscale[row0 + ai * HALF + m * 16] * sc : sc;
#pragma unroll
        for (int ai = 0; ai < 2; ++ai)
#pragma unroll
            for (int m = 0; m < 4; ++m) { const int row = row0 + ai * HALF + m * 16; bf16_t* rowp = O + (size_t)row * ldc + col0;
                const float rs = rsv[ai][m];
#pragma unroll
                for (int bj = 0; bj < 2; ++bj) { f32x4 v0 = acc[ai][bj][m][0], v1 = acc[ai][bj][m][1];
                    if (MODE == 1) {
#pragma unroll
                        for (int e = 0; e < 4; ++e) { const float a = fmaxf(v0[e], 0.f), b = fmaxf(v1[e], 0.f); v0[e] = a * a; v1[e] = b * b; }
                    } else { v0 = v0 * rs; v1 = v1 * rs; }
                    *(u32x4*)(rowp + bj * HALF) = pack8(v0, v1); } }
    }
};
struct EpiQup {
    static constexpr bool PERM = true;
    bf16_t* O; const float* rstd; const float* cost; const float* sint;
    __device__ __forceinline__ void operator()(const Acc& acc, const Unit& u, int wr, int wc, int fr, int fq) const {
        const int row0 = u.pm * BM + wr * 64 + fr, col0 = u.pn * BM + wc * 32 + 8 * fq;
        int i0v[2]; bool ropev[2];
#pragma unroll
        for (int bj = 0; bj < 2; ++bj) { const int jj = (col0 + bj * HALF) % 192; ropev[bj] = jj >= 128; i0v[bj] = ropev[bj] ? ((jj - 128) >> 3) * 4 : 0; }
#pragma unroll
        for (int ai = 0; ai < 2; ++ai) {
            float rsv[4]; f32x4 csv[4][2], snv[4][2];
#pragma unroll
            for (int m = 0; m < 4; ++m) { const int row = row0 + ai * HALF + m * 16; rsv[m] = rstd[row] * QSC; const int pos = row & (SEQ - 1);
#pragma unroll
                for (int bj = 0; bj < 2; ++bj) { csv[m][bj] = *(const f32x4*)(cost + pos * 32 + i0v[bj]); snv[m][bj] = *(const f32x4*)(sint + pos * 32 + i0v[bj]); } }
#pragma unroll
            for (int m = 0; m < 4; ++m) { const int row = row0 + ai * HALF + m * 16; bf16_t* rowp = O + (size_t)row * QW + col0;
#pragma unroll
                for (int bj = 0; bj < 2; ++bj) { f32x4 v0 = acc[ai][bj][m][0] * rsv[m], v1 = acc[ai][bj][m][1] * rsv[m];
                    if (ropev[bj]) { const f32x4 cs = csv[m][bj], sn = snv[m][bj]; const f32x4 o1 = v0 * cs - v1 * sn, o2 = v0 * sn + v1 * cs; v0 = o1; v1 = o2; }
                    *(u32x4*)(rowp + bj * HALF) = pack8(v0, v1); } }
        }
    }
};
struct EpiBranch {
    static constexpr bool PERM = true;
    bf16_t* O; const bf16_t* proj;
    __device__ __forceinline__ void operator()(const Acc& acc, const Unit& u, int wr, int wc, int fr, int fq) const {
        const int row0 = u.pm * BM + wr * 64 + fr, col0 = u.pn * BM + wc * 32 + 8 * fq;
        const int gcol = (u.sel ? PC_GM : PC_GF) + col0;
#pragma unroll
        for (int ai = 0; ai < 2; ++ai) {
            u32x4 gwv[4][2], pwv[4][2];
#pragma unroll
            for (int m = 0; m < 4; ++m) { const int row = row0 + ai * HALF + m * 16; const bf16_t* gp = proj + (size_t)row * NPROJ + gcol; const bf16_t* rowp = O + (size_t)row * DMODEL + col0;
#pragma unroll
                for (int bj = 0; bj < 2; ++bj) { gwv[m][bj] = *(const u32x4*)(gp + bj * HALF); if (u.sel) pwv[m][bj] = *(const u32x4*)(rowp + bj * HALF); else pwv[m][bj] = (u32x4){0u, 0u, 0u, 0u}; } }
#pragma unroll
            for (int m = 0; m < 4; ++m) { const int row = row0 + ai * HALF + m * 16; bf16_t* rowp = O + (size_t)row * DMODEL + col0;
#pragma unroll
                for (int bj = 0; bj < 2; ++bj) { f32x4 v0 = acc[ai][bj][m][0], v1 = acc[ai][bj][m][1];
                    const u32x4 gw = gwv[m][bj], pw = pwv[m][bj];
                    v0[0] *= sigmoidf_(bflo(gw.x)); v0[1] *= sigmoidf_(bfhi(gw.x)); v0[2] *= sigmoidf_(bflo(gw.y)); v0[3] *= sigmoidf_(bfhi(gw.y));
                    v1[0] *= sigmoidf_(bflo(gw.z)); v1[1] *= sigmoidf_(bfhi(gw.z)); v1[2] *= sigmoidf_(bflo(gw.w)); v1[3] *= sigmoidf_(bfhi(gw.w));
                    v0[0] += bflo(pw.x); v0[1] += bfhi(pw.x); v0[2] += bflo(pw.y); v0[3] += bfhi(pw.y);
                    v1[0] += bflo(pw.z); v1[1] += bfhi(pw.z); v1[2] += bflo(pw.w); v1[3] += bfhi(pw.w);
                    *(u32x4*)(rowp + bj * HALF) = pack8(v0, v1); } }
        }
    }
};
struct EpiResid {
    static constexpr bool PERM = false;
    const float* base; float* out; const float* gate;
    __device__ __forceinline__ void operator()(const Acc& acc, const Unit& u, int wr, int wc, int fr, int fq) const {
        const int col0 = u.pn * BM + wc * 32 + 4 * fq;
        const float* gt = gate + (size_t)((u.pm * BM) >> 12) * NADA;
        f32x4 gvv[2][2];
#pragma unroll
        for (int bj = 0; bj < 2; ++bj)
#pragma unroll
            for (int n = 0; n < 2; ++n) gvv[bj][n] = *(const f32x4*)(gt + col0 + bj * HALF + n * 16);
#pragma unroll
        for (int bj = 0; bj < 2; ++bj)
#pragma unroll
            for (int ai = 0; ai < 2; ++ai) {
                f32x4 bsv[4][2];
#pragma unroll
                for (int m = 0; m < 4; ++m)
#pragma unroll
                    for (int n = 0; n < 2; ++n) { const size_t off = (size_t)(u.pm * BM + ai * HALF + wr * 64 + m * 16 + fr) * DMODEL + col0 + bj * HALF + n * 16; bsv[m][n] = __builtin_nontemporal_load((const f32x4*)(base + off)); }
#pragma unroll
                for (int m = 0; m < 4; ++m)
#pragma unroll
                    for (int n = 0; n < 2; ++n) { const size_t off = (size_t)(u.pm * BM + ai * HALF + wr * 64 + m * 16 + fr) * DMODEL + col0 + bj * HALF + n * 16;
                        *(f32x4*)(out + off) = bsv[m][n] * ALPHA + gvv[bj][n] * acc[ai][bj][m][n]; } }
    }
};
}

namespace att {
__device__ __forceinline__ int crow(int r, int hi) { return (r & 3) + 8 * (r >> 2) + 4 * hi; }
constexpr int BUF_STRIDE = 41216;
constexpr int WS_OFF = 3 * BUF_STRIDE;
constexpr int Q_OFF = WS_OFF + 2048;
constexpr float THR = 6.0f;

__device__ __forceinline__ void glds16(const void* gsrc, unsigned lds_dst) { unsigned keep;
    asm volatile("s_mov_b32 %0, m0\n\ts_mov_b32 m0, %2\n\ts_nop 0\n\tglobal_load_lds_dwordx4 %1, off\n\ts_mov_b32 m0, %0" : "=&s"(keep) : "v"(gsrc), "s"(lds_dst) : "memory"); }
__device__ __forceinline__ void glds4(const void* gsrc, unsigned lds_dst) { unsigned keep;
    asm volatile("s_mov_b32 %0, m0\n\ts_mov_b32 m0, %2\n\ts_nop 0\n\tglobal_load_lds_dword %1, off\n\ts_mov_b32 m0, %0" : "=&s"(keep) : "v"(gsrc), "s"(lds_dst) : "memory"); }

template <int DQK, int DV, bool FOX>
__device__ __forceinline__ void attn_unit(const bf16_t* Q, int ldq, const bf16_t* Ka, int ldka, const bf16_t* Kb, int ldkb,
                                          const bf16_t* V, int ldv, bf16_t* O, int ldo, const float* cum, const float* ncum, const float* tot, int qb, LAS unsigned char* lds) {
    constexpr int KROW = DQK * 2, KT_BYTES = 64 * KROW, VT_BYTES = DV * 128, CPR = DQK / 8;
    constexpr int NKL = (DQK * 8) / 512, NVL = (DV * 8) / 512, NCB = DV / 32, ND0 = DQK / 16;
    const int tid = threadIdx.x, lane = tid & 63, r = lane & 31, h = lane >> 5; const int w = __builtin_amdgcn_readfirstlane(tid >> 6);
    const int q0 = qb * 256;
    const int NT = 4 * qb + 4, ntw = 4 * qb + (w >> 1) + 1;
    LAS float* wsf = (LAS float*)(lds + WS_OFF) + w * 64;
    bf16x8 qf[ND0];
    { const bf16_t* qp = Q + (size_t)(q0 + 32 * w + r) * ldq + 8 * h;
#pragma unroll
      for (int d0 = 0; d0 < ND0; ++d0) qf[d0] = *(const bf16x8*)(qp + 16 * d0); }
    float cq = 0.f, basev = 0.f;
    if (FOX) {
        const float tv = tot[lane]; float incl = tv;
#pragma unroll
        for (int o_ = 1; o_ < 64; o_ <<= 1) { const float t_ = __shfl_up(incl, o_); if (lane >= o_) incl += t_; }
        basev = incl - tv;
        cq = cum[q0 + 32 * w + r] + __builtin_bit_cast(float, __builtin_amdgcn_readlane(__builtin_bit_cast(int, basev), 4 * qb + (w >> 1)));
    }
#define ATT_DMA(t, buf) do { const unsigned b_ = lds_u + (unsigned)(buf) * BUF_STRIDE; \
        _Pragma("unroll") for (int i = 0; i < NKL; ++i) { const int s_ = (w + 8 * i) * 64 + lane, key_ = s_ / CPR, cpos_ = s_ % CPR, c_ = (cpos_ & ~7) | ((cpos_ ^ (key_ >> 1)) & 7); \
            const bf16_t* gp = ((!FOX) && c_ >= 16) ? Kb + ((size_t)(t) * 64 + key_) * ldkb + (c_ - 16) * 8 : Ka + ((size_t)(t) * 64 + key_) * ldka + c_ * 8; \
            glds16(gp, (unsigned)__builtin_amdgcn_readfirstlane(b_ + (w + 8 * i) * 1024)); } \
        _Pragma("unroll") for (int i = 0; i < NVL; ++i) { const int piece_ = w + 8 * i, cb_ = piece_ >> 2, ks_ = piece_ & 3, key_ = 16 * ks_ + (lane >> 2); \
            glds16(V + ((size_t)(t) * 64 + key_) * ldv + cb_ * 32 + (lane & 3) * 8, (unsigned)__builtin_amdgcn_readfirstlane(b_ + KT_BYTES + piece_ * 1024)); } \
        if (FOX) { if (w == 0) glds4(ncum + (t) * 64 + lane, (unsigned)__builtin_amdgcn_readfirstlane(b_ + KT_BYTES + VT_BYTES)); } } while (0)
    const unsigned lds_u = (unsigned)(uintptr_t)lds;
    f32x16 o[NCB];
#pragma unroll
    for (int cb = 0; cb < NCB; ++cb)
#pragma unroll
        for (int i = 0; i < 16; ++i) o[cb][i] = 0.f;
    float mref = -1e30f, lsum = 0.f;
    const int kread0 = r * KROW;
    const int ksw = (r >> 1) & 7;
    const int vread0 = KT_BYTES + ((lane >> 4) & 1) * 32 + (lane & 3) * 8 + (4 * h + ((lane & 15) >> 2)) * 64;

#define ATT_WAIT_TILE() do { if (FOX) { if (w == 0) asm volatile("s_waitcnt vmcnt(3)" ::: "memory"); else asm volatile("s_waitcnt vmcnt(2)" ::: "memory"); } \
                             else asm volatile("s_waitcnt vmcnt(5)" ::: "memory"); } while (0)
    ATT_DMA(0, 0); ATT_DMA(1, 1); ATT_WAIT_TILE(); __builtin_amdgcn_s_barrier();
#pragma unroll
    for (int d0 = 0; d0 < ND0; ++d0) asm volatile("" : "+v"(qf[d0]));
    if (FOX) asm volatile("" : "+v"(cq), "+v"(basev));
    int bc = 0, bn2 = 2;
    for (int t = 0; t < NT; ++t) {
        if (t + 2 < NT) ATT_DMA(t + 2, bn2);
        if (t < ntw) {
            LAS unsigned char* b = lds + bc * BUF_STRIDE;
            f32x16 p0, p1;
            if (FOX) {
                const LAS float* ck = (const LAS float*)(b + KT_BYTES + VT_BYTES);
#pragma unroll
                for (int g = 0; g < 4; ++g) { const f32x4 c0 = *(const LAS f32x4*)(ck + 8 * g + 4 * h), c1 = *(const LAS f32x4*)(ck + 32 + 8 * g + 4 * h);
#pragma unroll
                    for (int e = 0; e < 4; ++e) { p0[4 * g + e] = c0[e]; p1[4 * g + e] = c1[e]; } }
            } else {
#pragma unroll
            for (int i = 0; i < 16; ++i) { p0[i] = 0.f; p1[i] = 0.f; }
            }
            {
                constexpr int GB = FOX ? 4 : 3;
#pragma unroll
                for (int g0 = 0; g0 < ND0; g0 += GB) { bf16x8 ka[GB], kb[GB];
#pragma unroll
                    for (int j = 0; j < GB; ++j) { const int c = 2 * (g0 + j) + h; const int co = ((c & ~7) | ((c ^ ksw) & 7)) * 16;
                        ka[j] = *(const LAS bf16x8*)(b + kread0 + co); kb[j] = *(const LAS bf16x8*)(b + kread0 + 32 * KROW + co); }
                    __builtin_amdgcn_sched_barrier(0);
#pragma unroll
                    for (int j = 0; j < GB; ++j) { p0 = __builtin_amdgcn_mfma_f32_32x32x16_bf16(ka[j], qf[g0 + j], p0, 0, 0, 0);
                                                   p1 = __builtin_amdgcn_mfma_f32_32x32x16_bf16(kb[j], qf[g0 + j], p1, 0, 0, 0); }
                    __builtin_amdgcn_sched_barrier(0); } }
            s16x4 vlo0[4], vhi0[4];
            if (FOX) {
#pragma unroll
                for (int ks = 0; ks < 4; ++ks) {
                    vlo0[ks] = __builtin_bit_cast(s16x4, __builtin_amdgcn_ds_read_tr16_b64_v4i16((LAS s16x4*)(b + vread0 + ks * 1024)));
                    vhi0[ks] = __builtin_bit_cast(s16x4, __builtin_amdgcn_ds_read_tr16_b64_v4i16((LAS s16x4*)(b + vread0 + ks * 1024 + 512))); }
                __builtin_amdgcn_sched_barrier(0);
            }
            float mloc = mref, cqt = 0.f;
            if (FOX) {
                cqt = cq - __builtin_bit_cast(float, __builtin_amdgcn_readlane(__builtin_bit_cast(int, basev), t));
                mloc = mref - cqt;
                if (t == ntw - 1) { const int qrel = 32 * (w & 1) + r;
#pragma unroll
                    for (int i = 0; i < 16; ++i) { const int kv = crow(i, h); if (kv > qrel) p0[i] = -INFINITY; if (kv + 32 > qrel) p1[i] = -INFINITY; } }
            }
            float rm = fmaxf(fmaxf(p0[0], p1[0]), p0[1]);
#pragma unroll
            for (int i = 1; i < 15; ++i) rm = fmaxf(fmaxf(rm, p1[i]), p0[i + 1]);
            rm = fmaxf(rm, p1[15]);
            { const auto rr_ = __builtin_amdgcn_permlane32_swap(__float_as_uint(rm), __float_as_uint(rm), false, false);
              rm = fmaxf(__uint_as_float(rr_[0]), __uint_as_float(rr_[1])); }
            const bool grow = rm > mloc + THR;
            if (__any(grow)) {
                const float mnew = grow ? rm : mloc; const float al = __builtin_amdgcn_exp2f(mloc - mnew);
                lsum *= al; mref = grow ? (mnew + cqt) : mref; mloc = mnew;
                if (h == 0) wsf[r] = al;
                asm volatile("s_waitcnt lgkmcnt(0)" ::: "memory");
#pragma unroll
                for (int g = 0; g < 4; ++g) { const f32x4 a4 = *(const LAS f32x4*)(wsf + 8 * g + 4 * h);
#pragma unroll
                    for (int cb = 0; cb < NCB; ++cb)
#pragma unroll
                        for (int e = 0; e < 4; ++e) o[cb][4 * g + e] *= a4[e]; }
            }
            float ps = 0.f; f32x2v ps2 = {0.f, 0.f};
#pragma unroll
            for (int i = 0; i < 16; i += 2) { const f32x2v ml = (f32x2v){mloc, mloc};
                const f32x2v a0 = (f32x2v){p0[i], p0[i + 1]} - ml, a1 = (f32x2v){p1[i], p1[i + 1]} - ml;
                f32x2v e0, e1; e0.x = __builtin_amdgcn_exp2f(a0.x); e0.y = __builtin_amdgcn_exp2f(a0.y); e1.x = __builtin_amdgcn_exp2f(a1.x); e1.y = __builtin_amdgcn_exp2f(a1.y);
                p0[i] = e0.x; p0[i + 1] = e0.y; p1[i] = e1.x; p1[i + 1] = e1.y; ps2 += e0 + e1; }
            ps = ps2.x + ps2.y;
            lsum += ps;
            bf16x8 pa[4];
            { u32x4 t0, t1, t2, t3;
              t0.x = pg8::cvt_pk_bf16(p0[0], p0[1]); t0.y = pg8::cvt_pk_bf16(p0[2], p0[3]); t0.z = pg8::cvt_pk_bf16(p0[4], p0[5]); t0.w = pg8::cvt_pk_bf16(p0[6], p0[7]);
              t1.x = pg8::cvt_pk_bf16(p0[8], p0[9]); t1.y = pg8::cvt_pk_bf16(p0[10], p0[11]); t1.z = pg8::cvt_pk_bf16(p0[12], p0[13]); t1.w = pg8::cvt_pk_bf16(p0[14], p0[15]);
              t2.x = pg8::cvt_pk_bf16(p1[0], p1[1]); t2.y = pg8::cvt_pk_bf16(p1[2], p1[3]); t2.z = pg8::cvt_pk_bf16(p1[4], p1[5]); t2.w = pg8::cvt_pk_bf16(p1[6], p1[7]);
              t3.x = pg8::cvt_pk_bf16(p1[8], p1[9]); t3.y = pg8::cvt_pk_bf16(p1[10], p1[11]); t3.z = pg8::cvt_pk_bf16(p1[12], p1[13]); t3.w = pg8::cvt_pk_bf16(p1[14], p1[15]);
              pa[0] = __builtin_bit_cast(bf16x8, t0); pa[1] = __builtin_bit_cast(bf16x8, t1); pa[2] = __builtin_bit_cast(bf16x8, t2); pa[3] = __builtin_bit_cast(bf16x8, t3); }
#pragma unroll
            for (int cb = 0; cb < NCB; ++cb) { s16x4 lo[4], hi[4];
#pragma unroll
                for (int ks = 0; ks < 4; ++ks) {
                    if (FOX && cb == 0) { lo[ks] = vlo0[ks]; hi[ks] = vhi0[ks]; }
                    else {
                    lo[ks] = __builtin_bit_cast(s16x4, __builtin_amdgcn_ds_read_tr16_b64_v4i16((LAS s16x4*)(b + vread0 + cb * 4096 + ks * 1024)));
                    hi[ks] = __builtin_bit_cast(s16x4, __builtin_amdgcn_ds_read_tr16_b64_v4i16((LAS s16x4*)(b + vread0 + cb * 4096 + ks * 1024 + 512))); } }
                __builtin_amdgcn_sched_barrier(0);
#pragma unroll
                for (int ks = 0; ks < 4; ++ks) { const bf16x8 vf = (bf16x8){lo[ks][0], lo[ks][1], lo[ks][2], lo[ks][3], hi[ks][0], hi[ks][1], hi[ks][2], hi[ks][3]};
                    o[cb] = __builtin_amdgcn_mfma_f32_32x32x16_bf16(pa[ks], vf, o[cb], 0, 0, 0); }
                __builtin_amdgcn_sched_barrier(0); }
        }
        if (t + 2 < NT) ATT_WAIT_TILE(); else asm volatile("s_waitcnt vmcnt(0)" ::: "memory");
        asm volatile("s_waitcnt lgkmcnt(0)" ::: "memory");
        __builtin_amdgcn_s_barrier();
        bc = (bc == 2) ? 0 : bc + 1; bn2 = (bn2 == 2) ? 0 : bn2 + 1;
    }
    lsum += __shfl_xor(lsum, 32);
    if (h == 0) wsf[r] = 1.0f / lsum;
    asm volatile("s_waitcnt lgkmcnt(0)" ::: "memory");
    bf16_t* Ow = O + (size_t)(q0 + 32 * w) * ldo;
#pragma unroll
    for (int i = 0; i < 16; ++i) { const int qr = crow(i, h); const float rl = wsf[qr];
#pragma unroll
        for (int cb = 0; cb < NCB; ++cb) Ow[(size_t)qr * ldo + 32 * cb + r] = (bf16_t)f2bf(o[cb][i] * rl); }
    asm volatile("s_waitcnt lgkmcnt(0)" ::: "memory");
#undef ATT_DMA
#undef ATT_WAIT_TILE
}
}


#define XB_TMO      128
#define XB_XCNT(j)  (256  + 64 * (j))
#define XB_XSUB(j)  (1280 + 64 * (j))
#define XB_XGEN(j)  (2304 + 64 * (j))
#define XB_TOP      3328
#define XB_TOPGEN   3392
#define XCD_BAR_WORDS 3456
#define XB_SPIN_CAP (1u << 18)
__device__ __forceinline__ unsigned xb_ld(unsigned* p)              { return __hip_atomic_load(p, __ATOMIC_RELAXED, __HIP_MEMORY_SCOPE_AGENT); }
__device__ __forceinline__ unsigned xb_add(unsigned* p, unsigned v) { return __hip_atomic_fetch_add(p, v, __ATOMIC_RELAXED, __HIP_MEMORY_SCOPE_AGENT); }
__device__ __forceinline__ unsigned xb_xcc_id() { return (unsigned)__builtin_amdgcn_s_getreg((3 << 11) | 20) & 0xFu; }
#define XB_SPIN(cond, bar) do { unsigned _sp = 0; while (cond) { __builtin_amdgcn_s_sleep(1); \
    if ((++_sp & 255u) == 0u) { if (xb_ld(&(bar)[XB_TMO])) break; if (_sp > XB_SPIN_CAP) { atomicAdd(&(bar)[XB_TMO], 1u); break; } } } } while (0)
struct XcdBarrier { unsigned* bar; unsigned x; volatile LAS unsigned* st; };
__device__ __forceinline__ XcdBarrier xcd_barrier_post(unsigned* bar, volatile LAS unsigned* st) {
    XcdBarrier b; b.bar = bar; b.x = xb_xcc_id(); b.st = st;
    if (threadIdx.x == 0) (void)xb_add(&bar[XB_XCNT(b.x)], 1u);
    return b;
}
__device__ __forceinline__ void xcd_barrier_complete(unsigned* bar, unsigned x, unsigned& nloc, unsigned& nx) {
    const unsigned G = gridDim.x * gridDim.y * gridDim.z;
    unsigned sum, cnt, mine, sp = 0u;
    for (;;) {
        sum = 0u; cnt = 0u; mine = 0u;
#pragma unroll
        for (unsigned j = 0; j < 16; ++j) { const unsigned c = xb_ld(&bar[XB_XCNT(j)]); sum += c; cnt += (c > 0u) ? 1u : 0u; mine = (j == x) ? c : mine; }
        if (sum == G) break;
        __builtin_amdgcn_s_sleep(1);
        if ((++sp & 255u) == 0u) { if (xb_ld(&bar[XB_TMO])) break; if (sp > XB_SPIN_CAP) { atomicAdd(&bar[XB_TMO], 1u); break; } }
    }
    nloc = mine > 0u ? mine : 1u; nx = cnt > 0u ? cnt : 1u;
}
__device__ __forceinline__ void xcd_barrier(unsigned* bar, unsigned x, volatile LAS unsigned* st) {
    asm volatile("s_waitcnt vmcnt(0)" ::: "memory");
    __syncthreads();
    if (threadIdx.x == 0) {
        __builtin_amdgcn_s_waitcnt(0);
        unsigned nloc = st[0], nx = st[1];
        if (nloc == 0u) { xcd_barrier_complete(bar, x, nloc, nx); st[0] = nloc; st[1] = nx; }
        const unsigned old = xb_add(&bar[XB_XSUB(x)], 1u);
        const unsigned gen = old / nloc;
        if (old + 1u == (gen + 1u) * nloc) {
            __builtin_amdgcn_fence(__ATOMIC_RELEASE, "agent");
            asm volatile("s_waitcnt vmcnt(0)" ::: "memory");
            const unsigned og = xb_add(&bar[XB_TOP], 1u);
            const unsigned tg = og / nx;
            if (og + 1u == (tg + 1u) * nx) xb_add(&bar[XB_TOPGEN], 1u);
            else XB_SPIN(xb_ld(&bar[XB_TOPGEN]) == tg, bar);
            __builtin_amdgcn_fence(__ATOMIC_ACQUIRE, "agent");
            xb_add(&bar[XB_XGEN(x)], 1u);
            asm volatile("s_waitcnt vmcnt(0)" ::: "memory");
        } else {
            XB_SPIN(xb_ld(&bar[XB_XGEN(x)]) == gen, bar);
            __builtin_amdgcn_fence(__ATOMIC_ACQUIRE, "agent");
            asm volatile("s_waitcnt vmcnt(0)" ::: "memory");
        }
    }
    __syncthreads();
}
constexpr int PTR_OFF = 139264, XB_ST_OFF = PTR_OFF + 512, CW_BAR = 1024;
__device__ __forceinline__ const void* ldptr(LAS unsigned char* lds, int k) {
    const LAS unsigned* p = (const LAS unsigned*)(lds + PTR_OFF) + 2 * k;
    const unsigned lo = __builtin_amdgcn_readfirstlane(p[0]), hi = __builtin_amdgcn_readfirstlane(p[1]);
    typedef __attribute__((address_space(1))) const void* gcptr_t;
    return (const void*)(gcptr_t)(((unsigned long long)hi << 32) | lo);
}
struct Args { const float* in[19]; float* out; unsigned char* ws; int ph_lo, ph_hi; };
constexpr int NPH = 13;

template <class MapF>
__device__ __forceinline__ void conv_item(const float* W, int K, int Nsrc, bf16_t* WT, LAS float* scr, int kb, int nb, int lane, const float* kscale, MapF mapf, bool nts = false) {
    const int k0 = 64 * kb, n0 = 64 * nb, r4 = lane >> 4, c4 = lane & 15; const int sc = mapf(n0 + 4 * c4);
    f32x4 v[16];
#pragma unroll
    for (int i = 0; i < 16; ++i) { const int kk = 4 * i + r4; v[i] = (f32x4){0.f, 0.f, 0.f, 0.f}; if (sc >= 0) v[i] = __builtin_nontemporal_load((const f32x4*)(W + (size_t)(k0 + kk) * Nsrc + sc)); }
#pragma unroll
    for (int i = 0; i < 16; ++i) { const int kk = 4 * i + r4; f32x4 t = v[i]; if (kscale) t = t * kscale[k0 + kk];
        LAS float* d = scr + kk * 65 + 4 * c4; d[0] = t[0]; d[1] = t[1]; d[2] = t[2]; d[3] = t[3]; }
    asm volatile("s_waitcnt lgkmcnt(0)" ::: "memory");
    const int c = lane & 7;
#pragma unroll
    for (int j = 0; j < 8; ++j) { const int n = (lane >> 3) + 8 * j; const LAS float* sp = scr + (8 * c) * 65 + n;
        u32x4 o; o.x = pk2(sp[0 * 65], sp[1 * 65]); o.y = pk2(sp[2 * 65], sp[3 * 65]); o.z = pk2(sp[4 * 65], sp[5 * 65]); o.w = pk2(sp[6 * 65], sp[7 * 65]);
        if (nts) __builtin_nontemporal_store(o, (u32x4*)(WT + (size_t)(n0 + n) * K + k0 + 8 * c)); else *(u32x4*)(WT + (size_t)(n0 + n) * K + k0 + 8 * c) = o; }
    asm volatile("s_waitcnt lgkmcnt(0)" ::: "memory");
}
__device__ __forceinline__ int rope_perm(int p) { return 4 * (p >> 3) + (p & 3) + 32 * ((p >> 2) & 1); }
__device__ __forceinline__ int map_win(int n) {
    if (n < PC_CQ) return n;
    if (n < PC_CKV) return 3088 + (n - PC_CQ);
    if (n < PC_F) return 3600 + (n - PC_CKV);
    if (n < PC_GF) { const int j = n - PC_F; if (j < 16) return 3072 + j; if (j >= 64 && j < 128) return 3856 + rope_perm(j - 64); return -1; }
    if (n < PC_GM) return 3920 + (n - PC_GF);
    return 5968 + (n - PC_GM);
}
__device__ __forceinline__ int map_wq(int n) { const int hh = n / 192, j = n % 192; return j < 128 ? n : hh * 192 + 128 + rope_perm(j - 128); }
__device__ __forceinline__ int map_id(int n) { return n; }

__global__ void __launch_bounds__(512, 2) fwd_kernel(Args a) {
    __builtin_assume(__builtin_amdgcn_workitem_id_y() == 0); __builtin_assume(__builtin_amdgcn_workitem_id_z() == 0);
    extern __shared__ __attribute__((aligned(16))) unsigned char lds_raw[];
    LAS unsigned char* lds = (LAS unsigned char*)lds_raw;
    const int tid = threadIdx.x, lane = tid & 63, wave = __builtin_amdgcn_readfirstlane(tid >> 6);
    const int G = gridDim.x, bx = blockIdx.x;
    const int gw = bx * 8 + wave, NGW = G * 8;
    LAS unsigned long long* ptab = (LAS unsigned long long*)(lds + PTR_OFF);
    if (tid == 0) {
        ptab[0] = (unsigned long long)a.in[0]; ptab[1] = (unsigned long long)a.in[1]; ptab[2] = (unsigned long long)a.in[2]; ptab[3] = (unsigned long long)a.in[3];
        ptab[4] = (unsigned long long)a.in[4]; ptab[5] = (unsigned long long)a.in[5]; ptab[6] = (unsigned long long)a.in[6]; ptab[7] = (unsigned long long)a.in[7];
        ptab[8] = (unsigned long long)a.in[8]; ptab[9] = (unsigned long long)a.in[9]; ptab[10] = (unsigned long long)a.in[10]; ptab[11] = (unsigned long long)a.in[11];
        ptab[12] = (unsigned long long)a.in[12]; ptab[13] = (unsigned long long)a.in[13]; ptab[14] = (unsigned long long)a.in[14]; ptab[15] = (unsigned long long)a.in[15];
        ptab[16] = (unsigned long long)a.in[16]; ptab[17] = (unsigned long long)a.in[17]; ptab[18] = (unsigned long long)a.in[18];
        ptab[19] = (unsigned long long)a.out; ptab[20] = (unsigned long long)a.ws;
    }
    if (tid == 1) { ((volatile LAS unsigned*)(lds + XB_ST_OFF))[0] = 0u; ((volatile LAS unsigned*)(lds + XB_ST_OFF))[1] = 0u; }
    __syncthreads();
    unsigned xb_x = 0;
    if (a.ph_hi - a.ph_lo > 1) { const XcdBarrier xb0 = xcd_barrier_post((unsigned*)a.ws + CW_BAR, (volatile LAS unsigned*)(lds + XB_ST_OFF)); xb_x = xb0.x; }
    if (a.ph_lo < 0) cg::this_grid().sync();
#define PTRF(k) ((const float*)ldptr(lds, (k)))
#define WSP(off) ((unsigned char*)ldptr(lds, 20) + (off))
#define OUTP ((float*)ldptr(lds, 19))
#define IN_x PTRF(0)
#define IN_cvec PTRF(1)
#define IN_w_ada PTRF(2)
#define IN_b_ada PTRF(3)
#define IN_w_in PTRF(4)
#define IN_b_forget PTRF(5)
#define IN_g_q PTRF(6)
#define IN_w_q PTRF(7)
#define IN_g_kv PTRF(8)
#define IN_w_kv PTRF(9)
#define IN_w_bf PTRF(10)
#define IN_w_bm PTRF(11)
#define IN_w_out PTRF(12)
#define IN_ln1_g PTRF(13)
#define IN_ln1_b PTRF(14)
#define IN_w_up PTRF(15)
#define IN_w_dn PTRF(16)
#define IN_ln2_g PTRF(17)
#define IN_ln2_b PTRF(18)
#define DECL_WS() asm volatile("" ::: "memory"); unsigned char* const ws = WSP(0); float* const out = OUTP; (void)out; \
    unsigned* const ctl = (unsigned*)(ws + WS_CTL); (void)ctl; \
    float* const mod = (float*)(ws + WS_MOD); float* const part = (float*)(ws + WS_PART); float* const cum = (float*)(ws + WS_CUM); (void)mod; (void)part; (void)cum; \
    float* const rstd_q = (float*)(ws + WS_RSTD); float* const rstd_kv = rstd_q + MTOK; (void)rstd_kv; \
    float* const cost = (float*)(ws + WS_ROPE); float* const sint = cost + SEQ * 32; (void)sint; \
    bf16_t* const krope = (bf16_t*)(ws + WS_KROPE); (void)krope; \
    bf16_t* const WinT = (bf16_t*)(ws + WS_WIN); bf16_t* const WupT = (bf16_t*)(ws + WS_WUP); bf16_t* const WdnT = (bf16_t*)(ws + WS_WDN); bf16_t* const WoutT = (bf16_t*)(ws + WS_WOUT); \
    bf16_t* const WbrT = (bf16_t*)(ws + WS_WBR); bf16_t* const WqT = (bf16_t*)(ws + WS_WQ); bf16_t* const WkvT = (bf16_t*)(ws + WS_WKV); \
    (void)WinT; (void)WupT; (void)WdnT; (void)WoutT; (void)WbrT; (void)WqT; (void)WkvT; \
    bf16_t* const proj = (bf16_t*)(ws + WS_PROJ); bf16_t* const hbuf = proj; bf16_t* const ubuf = (bf16_t*)(ws + WS_U); bf16_t* const ycat = ubuf; (void)hbuf; (void)ycat; \
    bf16_t* const qmla = (bf16_t*)(ws + WS_QMLA); bf16_t* const kvmla = (bf16_t*)(ws + WS_KVMLA); bf16_t* const merged = (bf16_t*)(ws + WS_MERGED); (void)qmla; (void)kvmla; (void)merged;

    const int lo = a.ph_lo, hi = a.ph_hi;
#ifndef PROBE_DUP
#define PROBE_DUP (-1)
#endif
#ifndef ATT_ONLY
#define ATT_ONLY 0
#endif
#define REPS(k) ((PROBE_DUP == (k)) ? 2 : 1)
#ifndef PHMASK
#define PHMASK 0x1fff
#endif
#define IN(k) (((PHMASK >> (k)) & 1) && lo <= (k) && (k) < hi)
#ifndef PROBE_SYNC
#define PROBE_SYNC 0
#endif
#define GRIDBAR() xcd_barrier((unsigned*)WSP(WS_CTL) + CW_BAR, xb_x, (volatile LAS unsigned*)(lds + XB_ST_OFF))
#define SEAM(k) do { if (IN(k) && IN((k) + 1)) { GRIDBAR(); if ((k) == 1) for (int q_ = 0; q_ < PROBE_SYNC; ++q_) GRIDBAR(); } } while (0)

    if (IN(0)) for (int rep = 0; rep < REPS(0); ++rep) { DECL_WS();
        const float* const wada_p = IN_w_ada; const float* const c_p = IN_cvec;
        LAS float* scr = (LAS float*)(lds + wave * 16640);
        constexpr int I_ADA = 48 * KC_ADA, I_IN = 32 * 128, I_UP = 32 * 128, I_DN = 128 * 32, I_OUT = 32 * 32, I_BR = 16 * 32, I_Q = 8 * 24, I_KV = 4 * 32;
        constexpr int NITEMS = I_ADA + I_IN + I_UP + I_DN + I_OUT + 2 * I_BR + I_Q + I_KV;
        for (int it = gw; it < NITEMS; it += NGW) {
            int r = it;
            if (r < I_ADA) {
                const int cb = r % 48, kc = r / 48, col = cb * 256 + lane * 4;
                f32x4 s0 = {0.f, 0.f, 0.f, 0.f}, s1 = {0.f, 0.f, 0.f, 0.f};
                const int kbeg = kc * (DMODEL / KC_ADA);
#pragma unroll 16
                for (int k = kbeg; k < kbeg + DMODEL / KC_ADA; ++k) {
                    const f32x4 wv = __builtin_nontemporal_load((const f32x4*)(wada_p + (size_t)k * NADA + col));
                    const float c0 = c_p[k], c1 = c_p[DMODEL + k];
                    const float a0 = c0 * sigmoidf_(c0), a1 = c1 * sigmoidf_(c1);
                    s0 += wv * a0; s1 += wv * a1;
                }
                *(f32x4*)(part + (size_t)(kc * 2 + 0) * NADA + col) = s0; *(f32x4*)(part + (size_t)(kc * 2 + 1) * NADA + col) = s1;
                continue;
            }
            r -= I_ADA;
            if (r < I_IN) { conv_item(IN_w_in, 2048, DIN, WinT, scr, r / 128, r % 128, lane, nullptr, map_win); continue; } r -= I_IN;
            if (r < I_UP) { conv_item(IN_w_up, 2048, DFF, WupT, scr, r / 128, r % 128, lane, nullptr, map_id, true); continue; } r -= I_UP;
            if (r < I_DN) { conv_item(IN_w_dn, 8192, DMODEL, WdnT, scr, r / 32, r % 32, lane, nullptr, map_id, true); continue; } r -= I_DN;
            if (r < I_OUT) { conv_item(IN_w_out, 2048, DMODEL, WoutT, scr, r / 32, r % 32, lane, nullptr, map_id, true); continue; } r -= I_OUT;
            if (r < I_BR) { conv_item(IN_w_bf, 1024, DMODEL, WbrT, scr, r / 32, r % 32, lane, nullptr, map_id, true); continue; } r -= I_BR;
            if (r < I_BR) { conv_item(IN_w_bm, 1024, DMODEL, WbrT + (size_t)2048 * 1024, scr, r / 32, r % 32, lane, nullptr, map_id, true); continue; } r -= I_BR;
            if (r < I_Q) { conv_item(IN_w_q, 512, QW, WqT, scr, r / 24, r % 24, lane, IN_g_q, map_wq); continue; } r -= I_Q;
            conv_item(IN_w_kv, 256, KVW, WkvT, scr, r / 32, r % 32, lane, IN_g_kv, map_id);
        }
        for (int e = bx * 512 + tid; e < SEQ * 32; e += G * 512) {
            const int pos = e >> 5, i = e & 31;
            const float inv = powf(10000.0f, -(float)(2 * i) / 64.0f);
            const float ang = (float)pos * inv;
            const double ad = (double)ang; const double n = rint(ad * 0.15915494309189535); const float rr = (float)(ad - n * 6.283185307179586);
            cost[e] = cosf(rr); sint[e] = sinf(rr);
        }
    }
    SEAM(0);
    if (IN(1)) for (int rep = 0; rep < REPS(1); ++rep) { DECL_WS();
        const float* const bada_p = IN_b_ada;
        for (int e = bx * 512 + tid; e < 2 * NADA; e += G * 512) { const int b = e / NADA, n = e % NADA; float s = bada_p[n];
#pragma unroll
            for (int kc = 0; kc < KC_ADA; ++kc) s += part[(size_t)(kc * 2 + b) * NADA + n];
            mod[e] = s; }
    }
    SEAM(1);
    if (IN(2)) for (int rep = 0; rep < REPS(2); ++rep) { DECL_WS();
        const float* const x_p = IN_x;
        for (int m = 4 * gw; m < MTOK; m += 4 * NGW) {
            const float* md = mod + (size_t)(m >> 12) * NADA; const f32x4* xr = (const f32x4*)(x_p + (size_t)m * DMODEL) + lane;
            f32x4 vr[4][8];
#pragma unroll
            for (int q = 0; q < 4; ++q)
#pragma unroll
                for (int j = 0; j < 8; ++j) vr[q][j] = __builtin_nontemporal_load(xr + 512 * q + 64 * j);
            u32x2* o8 = (u32x2*)(ubuf + (size_t)m * DMODEL) + lane;
            f32x4 shv[8], scv[8];
#pragma unroll
            for (int j = 0; j < 8; ++j) { const int col = 4 * lane + 256 * j; shv[j] = *(const f32x4*)(md + col); scv[j] = *(const f32x4*)(md + DMODEL + col) + 1.0f; }
#pragma unroll
            for (int q = 0; q < 4; ++q)
#pragma unroll
                for (int j = 0; j < 8; ++j) { const f32x4 uu = vr[q][j] * scv[j] + shv[j]; u32x2 wv; wv.x = pg8::cvt_pk_bf16(uu[0], uu[1]); wv.y = pg8::cvt_pk_bf16(uu[2], uu[3]); o8[512 * q + 64 * j] = wv; } }
    }
    SEAM(2);
    if (IN(3)) for (int rep = 0; rep < REPS(3); ++rep) { DECL_WS();
        pg8::Gemm g{ubuf, WinT, MTOK, NPROJ, DMODEL, DMODEL}; pg8::StaticOrder S; S.init(MTOK, NPROJ, G, bx);
        pg8::EpiBf16<0> E{proj, NPROJ, 4, C2F, nullptr};
        pg8::gemm_phase<pg8::EpiBf16<0>, pg8::StaticOrder>(lds, g, S, E);
    }
    SEAM(3);
    if (IN(4)) for (int rep = 0; rep < REPS(4); ++rep) { DECL_WS();
        if (gw < 128) {
            const int b = gw >> 6, ch = gw & 63; const float* const bfp = IN_b_forget; float* const totp = (float*)(ws + WS_TOT);
            const bf16_t* fp = proj + (size_t)(b * SEQ + ch * 64 + lane) * NPROJ + PC_F;
            const u32x4 f0 = *(const u32x4*)fp, f1 = *(const u32x4*)(fp + 8);
            float fz[16] = {bflo(f0.x), bfhi(f0.x), bflo(f0.y), bfhi(f0.y), bflo(f0.z), bfhi(f0.z), bflo(f0.w), bfhi(f0.w),
                            bflo(f1.x), bfhi(f1.x), bflo(f1.y), bfhi(f1.y), bflo(f1.z), bfhi(f1.z), bflo(f1.w), bfhi(f1.w)};
#pragma unroll
            for (int hh = 0; hh < 16; ++hh) { const float z = fz[hh] + bfp[hh]; float incl = (fminf(z, 0.f) - log1pf(__expf(-fabsf(z)))) * LOG2E;
#pragma unroll
                for (int o = 1; o < 64; o <<= 1) { const float t = __shfl_up(incl, o); if (lane >= o) incl += t; }
                cum[(size_t)(b * 16 + hh) * SEQ + ch * 64 + lane] = incl; ((float*)(ws + WS_NCUM))[(size_t)(b * 16 + hh) * SEQ + ch * 64 + lane] = -incl;
                if (lane == 63) totp[(b * 16 + hh) * 64 + ch] = incl; }
        }
        for (int m = gw; m < MTOK; m += NGW) {
            const bf16_t* pr = proj + (size_t)m * NPROJ;
            { const u32x4 v = *(const u32x4*)(pr + PC_CQ + lane * 8); float s = 0.f;
              s += bflo(v.x) * bflo(v.x) + bfhi(v.x) * bfhi(v.x) + bflo(v.y) * bflo(v.y) + bfhi(v.y) * bfhi(v.y) + bflo(v.z) * bflo(v.z) + bfhi(v.z) * bfhi(v.z) + bflo(v.w) * bflo(v.w) + bfhi(v.w) * bfhi(v.w);
              s = wave_sum(s); if (lane == 0) rstd_q[m] = 1.0f / sqrtf(s * (1.0f / 512.0f) + RMS_EPS); }
            { float s = 0.f; if (lane < 32) { const u32x4 v = *(const u32x4*)(pr + PC_CKV + lane * 8);
              s += bflo(v.x) * bflo(v.x) + bfhi(v.x) * bfhi(v.x) + bflo(v.y) * bflo(v.y) + bfhi(v.y) * bfhi(v.y) + bflo(v.z) * bflo(v.z) + bfhi(v.z) * bfhi(v.z) + bflo(v.w) * bflo(v.w) + bfhi(v.w) * bfhi(v.w); }
              s = wave_sum(s); if (lane == 0) rstd_kv[m] = 1.0f / sqrtf(s * (1.0f / 256.0f) + RMS_EPS); }
            if (lane < 8) { const u32x4 v = *(const u32x4*)(pr + PC_KR + lane * 8); const int pos = m & (SEQ - 1), i0 = lane * 4;
                const f32x4 cs = *(const f32x4*)(cost + pos * 32 + i0), sn = *(const f32x4*)(sint + pos * 32 + i0);
                const f32x4 x1 = {bflo(v.x), bfhi(v.x), bflo(v.y), bfhi(v.y)}, x2 = {bflo(v.z), bfhi(v.z), bflo(v.w), bfhi(v.w)};
                const f32x4 o1 = x1 * cs - x2 * sn, o2 = x1 * sn + x2 * cs;
                u32x4 wv; wv.x = pk2(o1[0], o1[1]); wv.y = pk2(o1[2], o1[3]); wv.z = pk2(o2[0], o2[1]); wv.w = pk2(o2[2], o2[3]);
                *(u32x4*)(krope + (size_t)m * 64 + lane * 8) = wv; }
        }
    }
    SEAM(4);
    if (IN(5)) for (int rep = 0; rep < REPS(5); ++rep) { DECL_WS();
        { pg8::Gemm g{proj + PC_CKV, WkvT, MTOK, KVW, 256, NPROJ}; pg8::StaticOrder S; S.init(MTOK, KVW, G, bx);
          pg8::EpiBf16<0> E{kvmla, KVW, 0, 1.f, rstd_kv};
          pg8::gemm_phase<pg8::EpiBf16<0>, pg8::StaticOrder>(lds, g, S, E); }
        { pg8::Gemm g{proj + PC_CQ, WqT, MTOK, QW, 512, NPROJ}; pg8::StaticOrder S; S.init(MTOK, QW, G, bx);
          pg8::EpiQup E{qmla, rstd_q, cost, sint};
          pg8::gemm_phase<pg8::EpiQup, pg8::StaticOrder>(lds, g, S, E); }
    }
    SEAM(5);
    if (IN(6)) { DECL_WS(); constexpr int rep = 0;
        LAS unsigned* qw = (LAS unsigned*)(lds + att::Q_OFF);
        for (;;) {
            if (tid == 0) *qw = atomicAdd(ctl + 64 * rep, 1u);
            __syncthreads();
            const unsigned idx = *qw;
            __syncthreads();
            if (idx >= 768u) break;
            const int level = idx / 48, rr = idx % 48, qb = 15 - level;
            if (ATT_ONLY != 2 && (ATT_ONLY == 1 || rr < 16)) { const int b = rr >> 3, hh = rr & 7; const size_t rb = (size_t)b * SEQ;
                att::attn_unit<192, 128, false>(qmla + rb * QW + hh * 192, QW, kvmla + rb * KVW + hh * 256, KVW, krope + rb * 64, 64,
                                                kvmla + rb * KVW + hh * 256 + 128, KVW, ycat + rb * DMODEL + 1024 + hh * 128, DMODEL, nullptr, nullptr, nullptr, qb, lds);
            } else { const int bh = rr - 16, b = bh >> 4, hh = bh & 15; const size_t rb = (size_t)b * SEQ;
                att::attn_unit<64, 64, true>(proj + rb * NPROJ + PC_Q + hh * 64, NPROJ, proj + rb * NPROJ + PC_K + hh * 64, NPROJ, nullptr, 0,
                                             proj + rb * NPROJ + PC_V + hh * 64, NPROJ, ycat + rb * DMODEL + hh * 64, DMODEL, cum + (size_t)bh * SEQ, (const float*)(ws + WS_NCUM) + (size_t)bh * SEQ, (const float*)(ws + WS_TOT) + bh * 64, qb, lds);
            }
        }
    }
#if PROBE_DUP == 6
    if (IN(6)) { DECL_WS(); constexpr int rep = 1;
        LAS unsigned* qw = (LAS unsigned*)(lds + att::Q_OFF);
        for (;;) {
            if (tid == 0) *qw = atomicAdd(ctl + 64 * rep, 1u);
            __syncthreads();
            const unsigned idx = *qw;
            __syncthreads();
            if (idx >= 768u) break;
            const int level = idx / 48, rr = idx % 48, qb = 15 - level;
            if (ATT_ONLY != 2 && (ATT_ONLY == 1 || rr < 16)) { const int b = rr >> 3, hh = rr & 7; const size_t rb = (size_t)b * SEQ;
                att::attn_unit<192, 128, false>(qmla + rb * QW + hh * 192, QW, kvmla + rb * KVW + hh * 256, KVW, krope + rb * 64, 64,
                                                kvmla + rb * KVW + hh * 256 + 128, KVW, ycat + rb * DMODEL + 1024 + hh * 128, DMODEL, nullptr, nullptr, nullptr, qb, lds);
            } else { const int bh = rr - 16, b = bh >> 4, hh = bh & 15; const size_t rb = (size_t)b * SEQ;
                att::attn_unit<64, 64, true>(proj + rb * NPROJ + PC_Q + hh * 64, NPROJ, proj + rb * NPROJ + PC_K + hh * 64, NPROJ, nullptr, 0,
                                             proj + rb * NPROJ + PC_V + hh * 64, NPROJ, ycat + rb * DMODEL + hh * 64, DMODEL, cum + (size_t)bh * SEQ, (const float*)(ws + WS_NCUM) + (size_t)bh * SEQ, (const float*)(ws + WS_TOT) + bh * 64, qb, lds);
            }
        }
    }
#endif
    SEAM(6);
    if (IN(7)) for (int rep = 0; rep < REPS(7); ++rep) { DECL_WS();
        pg8::Gemm g{ycat, WbrT, MTOK, DMODEL, 1024, DMODEL}; pg8::BranchOrder S; S.init(MTOK, DMODEL, G, bx);
        pg8::EpiBranch E{merged, proj};
        pg8::gemm_phase<pg8::EpiBranch, pg8::BranchOrder>(lds, g, S, E);
    }
    SEAM(7);
    if (IN(8)) for (int rep = 0; rep < REPS(8); ++rep) { DECL_WS();
        pg8::Gemm g{merged, WoutT, MTOK, DMODEL, DMODEL, DMODEL}; pg8::StaticOrder S; S.init(MTOK, DMODEL, G, bx);
        pg8::EpiResid E{IN_x, out, mod + 2 * DMODEL};
        pg8::gemm_phase<pg8::EpiResid, pg8::StaticOrder>(lds, g, S, E);
    }
    SEAM(8);
    if (IN(9)) for (int rep = 0; rep < REPS(9); ++rep) { DECL_WS();
        const float* const lng_p = IN_ln1_g; const float* const lnb_p = IN_ln1_b;
        for (int m = 2 * gw; m < MTOK; m += 2 * NGW) {
            const float* md = mod + (size_t)(m >> 12) * NADA; f32x4* xr = (f32x4*)(out + (size_t)m * DMODEL) + lane;
            f32x4 va[8], vb[8]; float sa = 0.f, sb = 0.f;
#pragma unroll
            for (int j = 0; j < 8; ++j) { va[j] = __builtin_nontemporal_load(xr + 64 * j); vb[j] = __builtin_nontemporal_load(xr + 512 + 64 * j); }
#pragma unroll
            for (int j = 0; j < 8; ++j) { sa += (va[j][0] + va[j][1]) + (va[j][2] + va[j][3]); sb += (vb[j][0] + vb[j][1]) + (vb[j][2] + vb[j][3]); }
            const float mean_a = wave_sum(sa) * (1.0f / DMODEL), mean_b = wave_sum(sb) * (1.0f / DMODEL); float qa = 0.f, qb_ = 0.f;
#pragma unroll
            for (int j = 0; j < 8; ++j) { va[j] = va[j] - mean_a; vb[j] = vb[j] - mean_b;
                qa += (va[j][0] * va[j][0] + va[j][1] * va[j][1]) + (va[j][2] * va[j][2] + va[j][3] * va[j][3]);
                qb_ += (vb[j][0] * vb[j][0] + vb[j][1] * vb[j][1]) + (vb[j][2] * vb[j][2] + vb[j][3] * vb[j][3]); }
            const float rstd_a = 1.0f / sqrtf(wave_sum(qa) * (1.0f / DMODEL) + LN_EPS), rstd_b = 1.0f / sqrtf(wave_sum(qb_) * (1.0f / DMODEL) + LN_EPS);
            u32x2* o8 = (u32x2*)(ubuf + (size_t)m * DMODEL) + lane;
            f32x4 ggv[8], bbv[8], shv[8], scv[8];
#pragma unroll
            for (int j = 0; j < 8; ++j) { const int col = 4 * lane + 256 * j; ggv[j] = *(const f32x4*)(lng_p + col); bbv[j] = *(const f32x4*)(lnb_p + col);
                shv[j] = *(const f32x4*)(md + 3 * DMODEL + col); scv[j] = *(const f32x4*)(md + 4 * DMODEL + col); }
#pragma unroll
            for (int j = 0; j < 8; ++j) { const f32x4 gg = ggv[j], bb = bbv[j];
                const f32x4 ya = va[j] * rstd_a * gg + bb, yb = vb[j] * rstd_b * gg + bb; __builtin_nontemporal_store(ya, xr + 64 * j); __builtin_nontemporal_store(yb, xr + 512 + 64 * j);
                const f32x4 sh = shv[j], sc = scv[j] + 1.0f;
                const f32x4 ua = ya * sc + sh, ub = yb * sc + sh; u32x2 wa, wb;
                wa.x = pg8::cvt_pk_bf16(ua[0], ua[1]); wa.y = pg8::cvt_pk_bf16(ua[2], ua[3]); wb.x = pg8::cvt_pk_bf16(ub[0], ub[1]); wb.y = pg8::cvt_pk_bf16(ub[2], ub[3]);
                o8[64 * j] = wa; o8[512 + 64 * j] = wb; } }
    }
    SEAM(9);
    if (IN(10)) for (int rep = 0; rep < REPS(10); ++rep) { DECL_WS();
        pg8::Gemm g{ubuf, WupT, MTOK, DFF, DMODEL, DMODEL}; pg8::StaticOrder S; S.init(MTOK, DFF, G, bx);
        pg8::EpiBf16<1> E{hbuf, DFF, 0, 1.f, nullptr};
        pg8::gemm_phase<pg8::EpiBf16<1>, pg8::StaticOrder>(lds, g, S, E);
    }
    SEAM(10);
    if (IN(11)) for (int rep = 0; rep < REPS(11); ++rep) { DECL_WS();
        pg8::Gemm g{hbuf, WdnT, MTOK, DMODEL, DFF, DFF}; pg8::StaticOrder S; S.init(MTOK, DMODEL, G, bx);
        pg8::EpiResid E{out, out, mod + 5 * DMODEL};
        pg8::gemm_phase<pg8::EpiResid, pg8::StaticOrder>(lds, g, S, E);
    }
    SEAM(11);
    if (IN(12)) for (int rep = 0; rep < REPS(12); ++rep) { DECL_WS();
        const float* const lng_p = IN_ln2_g; const float* const lnb_p = IN_ln2_b;
        for (int m = 4 * gw; m < MTOK; m += 4 * NGW) { f32x4* xr = (f32x4*)(out + (size_t)m * DMODEL) + lane;
            f32x4 vr[4][8]; float sm[4], qq[4], rs[4];
#pragma unroll
            for (int q = 0; q < 4; ++q)
#pragma unroll
                for (int j = 0; j < 8; ++j) vr[q][j] = __builtin_nontemporal_load(xr + 512 * q + 64 * j);
            f32x4 ggv[8], bbv[8];
#pragma unroll
            for (int j = 0; j < 8; ++j) { const int col = 4 * lane + 256 * j; ggv[j] = *(const f32x4*)(lng_p + col); bbv[j] = *(const f32x4*)(lnb_p + col); }
#pragma unroll
            for (int q = 0; q < 4; ++q) { float s_ = 0.f;
#pragma unroll
                for (int j = 0; j < 8; ++j) s_ += (vr[q][j][0] + vr[q][j][1]) + (vr[q][j][2] + vr[q][j][3]);
                sm[q] = wave_sum(s_) * (1.0f / DMODEL); }
#pragma unroll
            for (int q = 0; q < 4; ++q) { float s2 = 0.f;
#pragma unroll
                for (int j = 0; j < 8; ++j) { vr[q][j] = vr[q][j] - sm[q]; s2 += (vr[q][j][0] * vr[q][j][0] + vr[q][j][1] * vr[q][j][1]) + (vr[q][j][2] * vr[q][j][2] + vr[q][j][3] * vr[q][j][3]); }
                qq[q] = wave_sum(s2); rs[q] = 1.0f / sqrtf(qq[q] * (1.0f / DMODEL) + LN_EPS); }
#pragma unroll
            for (int q = 0; q < 4; ++q)
#pragma unroll
                for (int j = 0; j < 8; ++j) __builtin_nontemporal_store(vr[q][j] * rs[q] * ggv[j] + bbv[j], xr + 512 * q + 64 * j); }
    }
#undef IN
#undef SEAM
#undef IN_x
#undef IN_cvec
#undef IN_w_ada
#undef IN_b_ada
#undef IN_w_in
#undef IN_b_forget
#undef IN_g_q
#undef IN_w_q
#undef IN_g_kv
#undef IN_w_kv
#undef IN_w_bf
#undef IN_w_bm
#undef IN_w_out
#undef IN_ln1_g
#undef IN_ln1_b
#undef IN_w_up
#undef IN_w_dn
#undef IN_ln2_g
#undef IN_ln2_b
}

extern "C" void kernel_launch(void* const* d_in, const int* in_sizes, int n_in, void* d_out, int out_size, void* d_ws, size_t ws_size, hipStream_t stream) {
    static int grid = 0;
    if (grid == 0) {
        if (n_in != 19 || out_size != MTOK * DMODEL || ws_size < WS_END) { fprintf(stderr, "kernel_launch: unexpected problem (n_in %d, out %d, ws %zu)\n", n_in, out_size, ws_size); grid = -1; return; }
        int dev = 0, cus = 0, per_cu = 0;
        if (hipGetDevice(&dev) != hipSuccess || hipDeviceGetAttribute(&cus, hipDeviceAttributeMultiprocessorCount, dev) != hipSuccess) { grid = -1; return; }
        if (hipFuncSetAttribute((const void*)fwd_kernel, hipFuncAttributeMaxDynamicSharedMemorySize, LDS_BYTES) != hipSuccess) { fprintf(stderr, "kernel_launch: hipFuncSetAttribute failed\n"); grid = -1; return; }
        if (hipOccupancyMaxActiveBlocksPerMultiprocessor(&per_cu, (const void*)fwd_kernel, 512, LDS_BYTES) != hipSuccess || per_cu < 1) { fprintf(stderr, "kernel_launch: occupancy query gave %d\n", per_cu); per_cu = 1; }
        (void)hipGetLastError();
        grid = cus * 1;
    }
    if (grid < 0) return;
    (void)hipMemsetAsync((char*)d_ws + WS_CTL, 0, 65536, stream);
    Args a{};
    for (int i = 0; i < 19; ++i) a.in[i] = (const float*)d_in[i];
    a.out = (float*)d_out; a.ws = (unsigned char*)d_ws;
#if MK_N_LAUNCHES == 1
    a.ph_lo = 0; a.ph_hi = NPH;
    void* args[] = {&a};
    hipError_t e = hipLaunchCooperativeKernel((const void*)fwd_kernel, dim3(grid), dim3(512), args, LDS_BYTES, stream);
    if (e != hipSuccess) fprintf(stderr, "kernel_launch: cooperative launch failed: %s (grid %d)\n", hipGetErrorString(e), grid);
#else
    for (int p = 0; p < NPH; ++p) { a.ph_lo = p; a.ph_hi = p + 1; hipLaunchKernelGGL(fwd_kernel, dim3(grid), dim3(512), LDS_BYTES, stream, a); }
#endif
}
```

```cpp
#include <hip/hip_runtime.h>
#include <hip/hip_cooperative_groups.h>
#include <cstdio>
#include <cstdint>
namespace cg = cooperative_groups;

#ifndef MK_N_LAUNCHES
#define PROBE_DUP (-1)
#define MK_N_LAUNCHES 1
#endif

#define LAS __attribute__((address_space(3)))
typedef unsigned short bf16_t;
typedef short bf16x8 __attribute__((ext_vector_type(8)));
typedef short s16x4 __attribute__((ext_vector_type(4)));
typedef float f32x4 __attribute__((ext_vector_type(4)));
typedef float f32x16 __attribute__((ext_vector_type(16)));
typedef unsigned u32x4 __attribute__((ext_vector_type(4)));
typedef unsigned u32x2 __attribute__((ext_vector_type(2)));
typedef float f32x2v __attribute__((ext_vector_type(2)));

constexpr int SEQ = 4096, DMODEL = 2048, MTOK = 8192, DIN = 8016, NPROJ = 8192, DFF = 8192, NADA = 12288;
constexpr int QW = 1536, KVW = 2048;
constexpr float LN_EPS = 1e-5f, RMS_EPS = 1e-6f;
constexpr float LOG2E = 1.4426950408889634f;
constexpr float ALPHA = 1.189207115002721f;
constexpr float C2F = 0.125f * LOG2E;
constexpr float QSC = 0.07216878364870322f * LOG2E;
constexpr int PC_Q = 0, PC_K = 1024, PC_V = 2048, PC_CQ = 3072, PC_CKV = 3584, PC_F = 3840, PC_KR = 3904, PC_GF = 4096, PC_GM = 6144;
constexpr int KC_ADA = 32;

constexpr size_t MiB = 1u << 20;
constexpr size_t WS_CTL = 0, WS_MOD = 1 * MiB, WS_PART = 340 * MiB, WS_TOT = 2 * MiB, WS_NCUM = 3 * MiB, WS_CUM = 4 * MiB, WS_RSTD = 4 * MiB + 512 * 1024, WS_ROPE = 5 * MiB, WS_KROPE = 6 * MiB;
constexpr size_t WS_WIN = 8 * MiB, WS_WUP = 40 * MiB, WS_WDN = 72 * MiB, WS_WOUT = 104 * MiB, WS_WBR = 112 * MiB, WS_WQ = 120 * MiB, WS_WKV = 122 * MiB;
constexpr size_t WS_PROJ = 124 * MiB;
constexpr size_t WS_U = 252 * MiB;
constexpr size_t WS_QMLA = 284 * MiB, WS_KVMLA = 308 * MiB;
constexpr size_t WS_MERGED = 284 * MiB;
constexpr size_t WS_END = 344 * MiB;

constexpr int LDS_BYTES = 147456;

__device__ __forceinline__ unsigned f2bf(float f) { unsigned u = __builtin_bit_cast(unsigned, f); return (u + 0x7fffu + ((u >> 16) & 1u)) >> 16; }
__device__ __forceinline__ unsigned pk2(float lo, float hi) { return f2bf(lo) | (f2bf(hi) << 16); }
__device__ __forceinline__ float bf2f(unsigned short b) { return __builtin_bit_cast(float, (unsigned)b << 16); }
__device__ __forceinline__ float bflo(unsigned w) { return __builtin_bit_cast(float, w << 16); }
__device__ __forceinline__ float bfhi(unsigned w) { return __builtin_bit_cast(float, w & 0xffff0000u); }
__device__ __forceinline__ float wave_sum(float v) {
#pragma unroll
    for (int o = 1; o < 64; o <<= 1) v += __shfl_xor(v, o);
    return v;
}
__device__ __forceinline__ float sigmoidf_(float x) { return __builtin_amdgcn_rcpf(1.0f + __builtin_amdgcn_exp2f(-1.4426950408889634f * x)); }

namespace pg8 {
constexpr int BM = 256, BK = 64, HALF = 128, HTB = HALF * BK * 2, STAGE_BYTES = 8 * HTB, NXCD = 8, WGM = 4;
__host__ __device__ __forceinline__ int lds_byte(int r, int c) { const int st = (r >> 4) * 2 + (c >> 5), rr = r & 15, cc = c & 31, ob = rr * 64 + cc * 2; return st * 1024 + (ob ^ (((ob >> 9) & 1) << 5)); }
__host__ __device__ __forceinline__ void stage_rc(int b, int& R, int& C) { const int st = b / 1024, sb = b % 1024, swz = sb ^ (((sb >> 9) & 1) << 5); R = (st >> 1) * 16 + swz / 64; C = (st & 1) * 32 + (swz % 64) / 2; }
__host__ __device__ __forceinline__ int perm32(int rho) { const int n = rho >> 4, i = rho & 15; return 8 * (i >> 2) + 4 * n + (i & 3); }

struct Unit { int pm, pn, pb, sel; long aoff; };
struct Gemm { const bf16_t* A; const bf16_t* Bt; int M, N, K, lda; };

__host__ __device__ __forceinline__ void map_tile(int wgid, int nM, int nN, int nwg, int& pm, int& pn) {
    if (false) { const int q = nwg / NXCD, r = nwg % NXCD, xcd = wgid % NXCD, off = wgid / NXCD; wgid = (xcd < r ? xcd * (q + 1) : r * (q + 1) + (xcd - r) * q) + off; }
    const int nig = WGM * nN, gid = wgid / nig, fm = gid * WGM, gsz = (nM - fm) < WGM ? (nM - fm) : WGM;
    pm = fm + ((wgid % nig) % gsz); pn = (wgid % nig) / gsz;
}
struct StaticOrder {
    int nM, nN, nwg, G, c;
    __device__ void init(int M, int N, int G_, int c_) { nM = M / BM; nN = N / BM; nwg = nM * nN; G = G_; c = c_; }
    __device__ bool next(int i, Unit& u) const {
        const long L = (long)i * G + c; if (L >= nwg) return false;
        map_tile((int)L, nM, nN, nwg, u.pm, u.pn); u.pb = u.pn; u.sel = 0; u.aoff = 0; return true;
    }
};
struct BranchOrder {
    int nM, nN, nwg, G, c;
    __device__ void init(int M, int N, int G_, int c_) { nM = M / BM; nN = N / BM; nwg = nM * nN; G = G_; c = c_; }
    __device__ bool next(int i, Unit& u) const {
        const long L = (long)(i >> 1) * G + c; if (L >= nwg) return false;
        map_tile((int)L, nM, nN, nwg, u.pm, u.pn); u.sel = i & 1; u.pb = u.pn + u.sel * nN; u.aoff = (long)u.sel * 1024 * 2; return true;
    }
};

__device__ __forceinline__ unsigned cvt_pk_bf16(float lo, float hi) { unsigned r; asm volatile("v_cvt_pk_bf16_f32 %0, %1, %2" : "=v"(r) : "v"(lo), "v"(hi)); return r; }

template <class Epi, class Sched, bool ALIGN_EPI = true>
__device__ __forceinline__ void gemm_phase(LAS unsigned char* lds, const Gemm g, const Sched& S, const Epi& E) {
    const int tid = threadIdx.x, wid = __builtin_amdgcn_readfirstlane(tid >> 6), lane = tid & 63, wr = wid >> 2, wc = wid & 3, fr = lane & 15, fq = lane >> 4;
    const int K = g.K, nt = K / BK, lda = g.lda;
    unsigned voffA[2], voffB[2];
#pragma unroll
    for (int i = 0; i < 2; ++i) { int R, C; stage_rc(tid * 16 + i * 8192, R, C); const int Rb = Epi::PERM ? ((R & ~31) + perm32(R & 31)) : R;
        voffA[i] = (unsigned)(R * lda + C) * 2u; voffB[i] = (unsigned)(Rb * K + C) * 2u; }
    const size_t kstep = (size_t)(BK * 2);
    const size_t hsA = (size_t)HALF * lda * 2, hsB = (size_t)HALF * K * 2;
    const size_t tsA = 2 * hsA, tsB = 2 * hsB;
    const unsigned ldsw = (unsigned)wid * 1024u;
    const int aoff = lds_byte(wr * 64 + fr, fq * 8), boff = lds_byte(wc * 32 + fr, fq * 8);
#define PG8_SA(b, h) (((b) * 2 + (h)) * HTB)
#define PG8_SB(b, h) ((4 + (b) * 2 + (h)) * HTB)
#define PG8_STAGE(bufoff, gbase, voff) do { _Pragma("unroll") for (int _i = 0; _i < 2; ++_i) \
        __builtin_amdgcn_global_load_lds((const unsigned*)((const char*)(gbase) + (voff)[_i]), (LAS unsigned*)(lds + (bufoff) + ldsw + _i * 8192), 16, 0, 0); } while (0)
#define PG8_LDA(dst, b, h) do { _Pragma("unroll") for (int m = 0; m < 4; ++m) _Pragma("unroll") for (int k = 0; k < 2; ++k) dst[m][k] = *(const LAS bf16x8*)(lds + PG8_SA(b, h) + aoff + m * 2048 + k * 1024); } while (0)
#define PG8_LDB(dst, b, h) do { _Pragma("unroll") for (int n = 0; n < 2; ++n) _Pragma("unroll") for (int k = 0; k < 2; ++k) dst[n][k] = *(const LAS bf16x8*)(lds + PG8_SB(b, h) + boff + n * 2048 + k * 1024); } while (0)
#define PG8_MMA(ai, bj, At, Bt) do { __builtin_amdgcn_s_setprio(1); _Pragma("unroll") for (int m = 0; m < 4; ++m) _Pragma("unroll") for (int n = 0; n < 2; ++n) _Pragma("unroll") for (int k = 0; k < 2; ++k) \
        acc[ai][bj][m][n] = __builtin_amdgcn_mfma_f32_16x16x32_bf16(Bt[n][k], At[m][k], acc[ai][bj][m][n], 0, 0, 0); __builtin_amdgcn_s_setprio(0); } while (0)
#define PG8_WAIT_V(n) asm volatile("s_waitcnt vmcnt(" #n ")" ::: "memory")
#define PG8_WAIT_L(n) asm volatile("s_waitcnt lgkmcnt(" #n ")" ::: "memory")
#define PG8_BAR __builtin_amdgcn_s_barrier()
#define PG8_SCHED __builtin_amdgcn_sched_barrier(0)
    Unit cur, nxt; int ui = 0;
    if (!S.next(0, cur)) return;
    f32x4 acc[2][2][4][2];
#pragma unroll
    for (int a = 0; a < 2; ++a)
#pragma unroll
        for (int b = 0; b < 2; ++b)
#pragma unroll
            for (int m = 0; m < 4; ++m)
#pragma unroll
                for (int n = 0; n < 2; ++n) acc[a][b][m][n] = (f32x4){0.f, 0.f, 0.f, 0.f};
    bf16x8 At[4][2], B0[2][2], B1[2][2];
    const char* cA = (const char*)g.A + (size_t)cur.pm * tsA + cur.aoff; const char* cB = (const char*)g.Bt + (size_t)cur.pb * tsB;
    PG8_STAGE(PG8_SB(0, 0), cB, voffB); PG8_STAGE(PG8_SB(0, 1), cB + hsB, voffB); PG8_STAGE(PG8_SA(0, 0), cA, voffA); PG8_STAGE(PG8_SA(0, 1), cA + hsA, voffA);
    if (wr == 1) PG8_BAR;
    PG8_WAIT_V(2); PG8_BAR;
    PG8_STAGE(PG8_SB(1, 0), cB + kstep, voffB); PG8_STAGE(PG8_SA(1, 0), cA + kstep, voffA); PG8_STAGE(PG8_SB(1, 1), cB + hsB + kstep, voffB);
    PG8_WAIT_V(6); PG8_BAR;
    for (;;) {
        const bool has_next = S.next(ui + 1, nxt);
        const char* nA = has_next ? (const char*)g.A + (size_t)nxt.pm * tsA + nxt.aoff : cA; const char* nB = has_next ? (const char*)g.Bt + (size_t)nxt.pb * tsB : cB;
        for (int t = 0; t < nt; t += 2) {
            const bool last = (t == nt - 2);
            const char* a1 = cA + (size_t)(t + 1) * kstep;
            const char* a2 = last ? nA : cA + (size_t)(t + 2) * kstep; const char* b2 = last ? nB : cB + (size_t)(t + 2) * kstep;
            const char* a3 = a2 + kstep; const char* b3 = b2 + kstep;
            PG8_LDB(B0, 0, 0); PG8_LDB(B1, 0, 1); PG8_SCHED; PG8_LDA(At, 0, 0); PG8_STAGE(PG8_SA(1, 1), a1 + hsA, voffA);
            PG8_WAIT_V(8); PG8_WAIT_L(0); PG8_BAR; PG8_MMA(0, 0, At, B0); PG8_MMA(0, 1, At, B1); PG8_BAR; PG8_SCHED;
            PG8_LDA(At, 0, 1); PG8_STAGE(PG8_SB(0, 0), b2, voffB); PG8_STAGE(PG8_SB(0, 1), b2 + hsB, voffB); PG8_STAGE(PG8_SA(0, 0), a2, voffA);
            PG8_WAIT_V(8); PG8_WAIT_L(0); PG8_BAR; PG8_MMA(1, 0, At, B0); PG8_MMA(1, 1, At, B1); PG8_BAR; PG8_SCHED;
            PG8_LDB(B0, 1, 0); PG8_LDB(B1, 1, 1); PG8_SCHED; PG8_LDA(At, 1, 0); PG8_STAGE(PG8_SA(0, 1), a2 + hsA, voffA);
            PG8_WAIT_V(8); PG8_WAIT_L(0); PG8_BAR; PG8_MMA(0, 0, At, B0); PG8_MMA(0, 1, At, B1); PG8_BAR; PG8_SCHED;
            PG8_LDA(At, 1, 1); PG8_STAGE(PG8_SB(1, 0), b3, voffB); PG8_STAGE(PG8_SB(1, 1), b3 + hsB, voffB); PG8_STAGE(PG8_SA(1, 0), a3, voffA);
            PG8_WAIT_V(8); PG8_WAIT_L(0); PG8_BAR; PG8_MMA(1, 0, At, B0); PG8_MMA(1, 1, At, B1); PG8_BAR; PG8_SCHED;
        }
        if constexpr (ALIGN_EPI) { if (wr == 0) PG8_BAR; }
        E(acc, cur, wr, wc, fr, fq);
        if (!has_next) break;
#pragma unroll
        for (int a = 0; a < 2; ++a)
#pragma unroll
            for (int b = 0; b < 2; ++b)
#pragma unroll
                for (int m = 0; m < 4; ++m)
#pragma unroll
                    for (int n = 0; n < 2; ++n) acc[a][b][m][n] = (f32x4){0.f, 0.f, 0.f, 0.f};
        cur = nxt; cA = nA; cB = nB; ++ui;
        if constexpr (ALIGN_EPI) { if (wr == 1) PG8_BAR; }
    }
    PG8_WAIT_V(0);
    if constexpr (!ALIGN_EPI) { if (wr == 0) PG8_BAR; }
    PG8_BAR;
#undef PG8_SA
#undef PG8_SB
#undef PG8_STAGE
#undef PG8_LDA
#undef PG8_LDB
#undef PG8_MMA
#undef PG8_WAIT_V
#undef PG8_WAIT_L
#undef PG8_BAR
#undef PG8_SCHED
}

typedef f32x4 Acc[2][2][4][2];

__device__ __forceinline__ u32x4 pack8(f32x4 v0, f32x4 v1) { u32x4 w; w.x = cvt_pk_bf16(v0[0], v0[1]); w.y = cvt_pk_bf16(v0[2], v0[3]); w.z = cvt_pk_bf16(v1[0], v1[1]); w.w = cvt_pk_bf16(v1[2], v1[3]); return w; }

template <int MODE> struct EpiBf16 {
    static constexpr bool PERM = true;
    bf16_t* O; int ldc; int nscale; float sc0; const float* rowscale;
    __device__ __forceinline__ void operator()(const Acc& acc, const Unit& u, int wr, int wc, int fr, int fq) const {
        const int row0 = u.pm * BM + wr * 64 + fr, col0 = u.pn * BM + wc * 32 + 8 * fq;
        const float sc = (u.pn < nscale) ? sc0 : 1.f;
        float rsv[2][4];
#pragma unroll
        for (int ai = 0; ai < 2; ++ai)
#pragma unroll
            for (int m = 0; m < 4; ++m) rsv[ai][m] = rowscale ? rowscale[row0 + ai * HALF + m * 16] * sc : sc;
#pragma unroll
        for (int ai = 0; ai < 2; ++ai)
#pragma unroll
            for (int m = 0; m < 4; ++m) { const int row = row0 + ai * HALF + m * 16; bf16_t* rowp = O + (size_t)row * ldc + col0;
                const float rs = rsv[ai][m];
#pragma unroll
                for (int bj = 0; bj < 2; ++bj) { f32x4 v0 = acc[ai][bj][m][0], v1 = acc[ai][bj][m][1];
                    if (MODE == 1) {
#pragma unroll
                        for (int e = 0; e < 4; ++e) { const float a = fmaxf(v0[e], 0.f), b = fmaxf(v1[e], 0.f); v0[e] = a * a; v1[e] = b * b; }
                    } else { v0 = v0 * rs; v1 = v1 * rs; }
                    *(u32x4*)(rowp + bj * HALF) = pack8(v0, v1); } }
    }
};
struct EpiQup {
    static constexpr bool PERM = true;
    bf16_t* O; const float* rstd; const float* cost; const float* sint;
    __device__ __forceinline__ void operator()(const Acc& acc, const Unit& u, int wr, int wc, int fr, int fq) const {
        const int row0 = u.pm * BM + wr * 64 + fr, col0 = u.pn * BM + wc * 32 + 8 * fq;
        int i0v[2]; bool ropev[2];
#pragma unroll
        for (int bj = 0; bj < 2; ++bj) { const int jj = (col0 + bj * HALF) % 192; ropev[bj] = jj >= 128; i0v[bj] = ropev[bj] ? ((jj - 128) >> 3) * 4 : 0; }
#pragma unroll
        for (int ai = 0; ai < 2; ++ai) {
            float rsv[4]; f32x4 csv[4][2], snv[4][2];
#pragma unroll
            for (int m = 0; m < 4; ++m) { const int row = row0 + ai * HALF + m * 16; rsv[m] = rstd[row] * QSC; const int pos = row & (SEQ - 1);
#pragma unroll
                for (int bj = 0; bj < 2; ++bj) { csv[m][bj] = *(const f32x4*)(cost + pos * 32 + i0v[bj]); snv[m][bj] = *(const f32x4*)(sint + pos * 32 + i0v[bj]); } }
#pragma unroll
            for (int m = 0; m < 4; ++m) { const int row = row0 + ai * HALF + m * 16; bf16_t* rowp = O + (size_t)row * QW + col0;
#pragma unroll
                for (int bj = 0; bj < 2; ++bj) { f32x4 v0 = acc[ai][bj][m][0] * rsv[m], v1 = acc[ai][bj][m][1] * rsv[m];
                    if (ropev[bj]) { const f32x4 cs = csv[m][bj], sn = snv[m][bj]; const f32x4 o1 = v0 * cs - v1 * sn, o2 = v0 * sn + v1 * cs; v0 = o1; v1 = o2; }
                    *(u32x4*)(rowp + bj * HALF) = pack8(v0, v1); } }
        }
    }
};
struct EpiBranch {
    static constexpr bool PERM = true;
    bf16_t* O; const bf16_t* proj;
    __device__ __forceinline__ void operator()(const Acc& acc, const Unit& u, int wr, int wc, int fr, int fq) const {
        const int row0 = u.pm * BM + wr * 64 + fr, col0 = u.pn * BM + wc * 32 + 8 * fq;
        const int gcol = (u.sel ? PC_GM : PC_GF) + col0;
#pragma unroll
        for (int ai = 0; ai < 2; ++ai) {
            u32x4 gwv[4][2], pwv[4][2];
#pragma unroll
            for (int m = 0; m < 4; ++m) { const int row = row0 + ai * HALF + m * 16; const bf16_t* gp = proj + (size_t)row * NPROJ + gcol; const bf16_t* rowp = O + (size_t)row * DMODEL + col0;
#pragma unroll
                for (int bj = 0; bj < 2; ++bj) { gwv[m][bj] = *(const u32x4*)(gp + bj * HALF); if (u.sel) pwv[m][bj] = *(const u32x4*)(rowp + bj * HALF); else pwv[m][bj] = (u32x4){0u, 0u, 0u, 0u}; } }
#pragma unroll
            for (int m = 0; m < 4; ++m) { const int row = row0 + ai * HALF + m * 16; bf16_t* rowp = O + (size_t)row * DMODEL + col0;
#pragma unroll
                for (int bj = 0; bj < 2; ++bj) { f32x4 v0 = acc[ai][bj][m][0], v1 = acc[ai][bj][m][1];
                    const u32x4 gw = gwv[m][bj], pw = pwv[m][bj];
                    v0[0] *= sigmoidf_(bflo(gw.x)); v0[1] *= sigmoidf_(bfhi(gw.x)); v0[2] *= sigmoidf_(bflo(gw.y)); v0[3] *= sigmoidf_(bfhi(gw.y));
                    v1[0] *= sigmoidf_(bflo(gw.z)); v1[1] *= sigmoidf_(bfhi(gw.z)); v1[2] *= sigmoidf_(bflo(gw.w)); v1[3] *= sigmoidf_(bfhi(gw.w));
                    v0[0] += bflo(pw.x); v0[1] += bfhi(pw.x); v0[2] += bflo(pw.y); v0[3] += bfhi(pw.y);
                    v1[0] += bflo(pw.z); v1[1] += bfhi(pw.z); v1[2] += bflo(pw.w); v1[3] += bfhi(pw.w);
                    *(u32x4*)(rowp + bj * HALF) = pack8(v0, v1); } }
        }
    }
};
struct EpiResid {
    static constexpr bool PERM = false;
    const float* base; float* out; const float* gate;
    __device__ __forceinline__ void operator()(const Acc& acc, const Unit& u, int wr, int wc, int fr, int fq) const {
        const int col0 = u.pn * BM + wc * 32 + 4 * fq;
        const float* gt = gate + (size_t)((u.pm * BM) >> 12) * NADA;
        f32x4 gvv[2][2];
#pragma unroll
        for (int bj = 0; bj < 2; ++bj)
#pragma unroll
            for (int n = 0; n < 2; ++n) gvv[bj][n] = *(const f32x4*)(gt + col0 + bj * HALF + n * 16);
#pragma unroll
        for (int bj = 0; bj < 2; ++bj)
#pragma unroll
            for (int ai = 0; ai < 2; ++ai) {
                f32x4 bsv[4][2];
#pragma unroll
                for (int m = 0; m < 4; ++m)
#pragma unroll
                    for (int n = 0; n < 2; ++n) { const size_t off = (size_t)(u.pm * BM + ai * HALF + wr * 64 + m * 16 + fr) * DMODEL + col0 + bj * HALF + n * 16; bsv[m][n] = __builtin_nontemporal_load((const f32x4*)(base + off)); }
#pragma unroll
                for (int m = 0; m < 4; ++m)
#pragma unroll
                    for (int n = 0; n < 2; ++n) { const size_t off = (size_t)(u.pm * BM + ai * HALF + wr * 64 + m * 16 + fr) * DMODEL + col0 + bj * HALF + n * 16;
                        *(f32x4*)(out + off) = bsv[m][n] * ALPHA + gvv[bj][n] * acc[ai][bj][m][n]; } }
    }
};
}

namespace att {
__device__ __forceinline__ int crow(int r, int hi) { return (r & 3) + 8 * (r >> 2) + 4 * hi; }
constexpr int BUF_STRIDE = 41216;
constexpr int WS_OFF = 3 * BUF_STRIDE;
constexpr int Q_OFF = WS_OFF + 2048;
constexpr float THR = 6.0f;

__device__ __forceinline__ void glds16(const void* gsrc, unsigned lds_dst) { unsigned keep;
    asm volatile("s_mov_b32 %0, m0\n\ts_mov_b32 m0, %2\n\ts_nop 0\n\tglobal_load_lds_dwordx4 %1, off\n\ts_mov_b32 m0, %0" : "=&s"(keep) : "v"(gsrc), "s"(lds_dst) : "memory"); }
__device__ __forceinline__ void glds4(const void* gsrc, unsigned lds_dst) { unsigned keep;
    asm volatile("s_mov_b32 %0, m0\n\ts_mov_b32 m0, %2\n\ts_nop 0\n\tglobal_load_lds_dword %1, off\n\ts_mov_b32 m0, %0" : "=&s"(keep) : "v"(gsrc), "s"(lds_dst) : "memory"); }

template <int DQK, int DV, bool FOX>
__device__ __forceinline__ void attn_unit(const bf16_t* Q, int ldq, const bf16_t* Ka, int ldka, const bf16_t* Kb, int ldkb,
                                          const bf16_t* V, int ldv, bf16_t* O, int ldo, const float* cum, const float* ncum, const float* tot, int qb, LAS unsigned char* lds) {
    constexpr int KROW = DQK * 2, KT_BYTES = 64 * KROW, VT_BYTES = DV * 128, CPR = DQK / 8;
    constexpr int NKL = (DQK * 8) / 512, NVL = (DV * 8) / 512, NCB = DV / 32, ND0 = DQK / 16;
    const int tid = threadIdx.x, lane = tid & 63, r = lane & 31, h = lane >> 5; const int w = __builtin_amdgcn_readfirstlane(tid >> 6);
    const int q0 = qb * 256;
    const int NT = 4 * qb + 4, ntw = 4 * qb + (w >> 1) + 1;
    LAS float* wsf = (LAS float*)(lds + WS_OFF) + w * 64;
    bf16x8 qf[ND0];
    { const bf16_t* qp = Q + (size_t)(q0 + 32 * w + r) * ldq + 8 * h;
#pragma unroll
      for (int d0 = 0; d0 < ND0; ++d0) qf[d0] = *(const bf16x8*)(qp + 16 * d0); }
    float cq = 0.f, basev = 0.f;
    if (FOX) {
        const float tv = tot[lane]; float incl = tv;
#pragma unroll
        for (int o_ = 1; o_ < 64; o_ <<= 1) { const float t_ = __shfl_up(incl, o_); if (lane >= o_) incl += t_; }
        basev = incl - tv;
        cq = cum[q0 + 32 * w + r] + __builtin_bit_cast(float, __builtin_amdgcn_readlane(__builtin_bit_cast(int, basev), 4 * qb + (w >> 1)));
    }
#define ATT_DMA(t, buf) do { const unsigned b_ = lds_u + (unsigned)(buf) * BUF_STRIDE; \
        _Pragma("unroll") for (int i = 0; i < NKL; ++i) { const int s_ = (w + 8 * i) * 64 + lane, key_ = s_ / CPR, cpos_ = s_ % CPR, c_ = (cpos_ & ~7) | ((cpos_ ^ (key_ >> 1)) & 7); \
            const bf16_t* gp = ((!FOX) && c_ >= 16) ? Kb + ((size_t)(t) * 64 + key_) * ldkb + (c_ - 16) * 8 : Ka + ((size_t)(t) * 64 + key_) * ldka + c_ * 8; \
            glds16(gp, (unsigned)__builtin_amdgcn_readfirstlane(b_ + (w + 8 * i) * 1024)); } \
        _Pragma("unroll") for (int i = 0; i < NVL; ++i) { const int piece_ = w + 8 * i, cb_ = piece_ >> 2, ks_ = piece_ & 3, key_ = 16 * ks_ + (lane >> 2); \
            glds16(V + ((size_t)(t) * 64 + key_) * ldv + cb_ * 32 + (lane & 3) * 8, (unsigned)__builtin_amdgcn_readfirstlane(b_ + KT_BYTES + piece_ * 1024)); } \
        if (FOX) { if (w == 0) glds4(ncum + (t) * 64 + lane, (unsigned)__builtin_amdgcn_readfirstlane(b_ + KT_BYTES + VT_BYTES)); } } while (0)
    const unsigned lds_u = (unsigned)(uintptr_t)lds;
    f32x16 o[NCB];
#pragma unroll
    for (int cb = 0; cb < NCB; ++cb)
#pragma unroll
        for (int i = 0; i < 16; ++i) o[cb][i] = 0.f;
    float mref = -1e30f, lsum = 0.f;
    const int kread0 = r * KROW;
    const int ksw = (r >> 1) & 7;
    const int vread0 = KT_BYTES + ((lane >> 4) & 1) * 32 + (lane & 3) * 8 + (4 * h + ((lane & 15) >> 2)) * 64;

#define ATT_WAIT_TILE() do { if (FOX) { if (w == 0) asm volatile("s_waitcnt vmcnt(3)" ::: "memory"); else asm volatile("s_waitcnt vmcnt(2)" ::: "memory"); } \
                             else asm volatile("s_waitcnt vmcnt(5)" ::: "memory"); } while (0)
    ATT_DMA(0, 0); ATT_DMA(1, 1); ATT_WAIT_TILE(); __builtin_amdgcn_s_barrier();
#pragma unroll
    for (int d0 = 0; d0 < ND0; ++d0) asm volatile("" : "+v"(qf[d0]));
    if (FOX) asm volatile("" : "+v"(cq), "+v"(basev));
    int bc = 0, bn2 = 2;
    for (int t = 0; t < NT; ++t) {
        if (t + 2 < NT) ATT_DMA(t + 2, bn2);
        if (t < ntw) {
            LAS unsigned char* b = lds + bc * BUF_STRIDE;
            f32x16 p0, p1;
            if (FOX) {
                const LAS float* ck = (const LAS float*)(b + KT_BYTES + VT_BYTES);
#pragma unroll
                for (int g = 0; g < 4; ++g) { const f32x4 c0 = *(const LAS f32x4*)(ck + 8 * g + 4 * h), c1 = *(const LAS f32x4*)(ck + 32 + 8 * g + 4 * h);
#pragma unroll
                    for (int e = 0; e < 4; ++e) { p0[4 * g + e] = c0[e]; p1[4 * g + e] = c1[e]; } }
            } else {
#pragma unroll
            for (int i = 0; i < 16; ++i) { p0[i] = 0.f; p1[i] = 0.f; }
            }
            {
                constexpr int GB = FOX ? 4 : 3;
#pragma unroll
                for (int g0 = 0; g0 < ND0; g0 += GB) { bf16x8 ka[GB], kb[GB];
#pragma unroll
                    for (int j = 0; j < GB; ++j) { const int c = 2 * (g0 + j) + h; const int co = ((c & ~7) | ((c ^ ksw) & 7)) * 16;
                        ka[j] = *(const LAS bf16x8*)(b + kread0 + co); kb[j] = *(const LAS bf16x8*)(b + kread0 + 32 * KROW + co); }
                    __builtin_amdgcn_sched_barrier(0);
#pragma unroll
                    for (int j = 0; j < GB; ++j) { p0 = __builtin_amdgcn_mfma_f32_32x32x16_bf16(ka[j], qf[g0 + j], p0, 0, 0, 0);
                                                   p1 = __builtin_amdgcn_mfma_f32_32x32x16_bf16(kb[j], qf[g0 + j], p1, 0, 0, 0); }
                    __builtin_amdgcn_sched_barrier(0); } }
            s16x4 vlo0[4], vhi0[4];
            if (FOX) {
#pragma unroll
                for (int ks = 0; ks < 4; ++ks) {
                    vlo0[ks] = __builtin_bit_cast(s16x4, __builtin_amdgcn_ds_read_tr16_b64_v4i16((LAS s16x4*)(b + vread0 + ks * 1024)));
                    vhi0[ks] = __builtin_bit_cast(s16x4, __builtin_amdgcn_ds_read_tr16_b64_v4i16((LAS s16x4*)(b + vread0 + ks * 1024 + 512))); }
                __builtin_amdgcn_sched_barrier(0);
            }
            float mloc = mref, cqt = 0.f;
            if (FOX) {
                cqt = cq - __builtin_bit_cast(float, __builtin_amdgcn_readlane(__builtin_bit_cast(int, basev), t));
                mloc = mref - cqt;
                if (t == ntw - 1) { const int qrel = 32 * (w & 1) + r;
#pragma unroll
                    for (int i = 0; i < 16; ++i) { const int kv = crow(i, h); if (kv > qrel) p0[i] = -INFINITY; if (kv + 32 > qrel) p1[i] = -INFINITY; } }
            }
            float rm = fmaxf(fmaxf(p0[0], p1[0]), p0[1]);
#pragma unroll
            for (int i = 1; i < 15; ++i) rm = fmaxf(fmaxf(rm, p1[i]), p0[i + 1]);
            rm = fmaxf(rm, p1[15]);
            { const auto rr_ = __builtin_amdgcn_permlane32_swap(__float_as_uint(rm), __float_as_uint(rm), false, false);
              rm = fmaxf(__uint_as_float(rr_[0]), __uint_as_float(rr_[1])); }
            const bool grow = rm > mloc + THR;
            if (__any(grow)) {
                const float mnew = grow ? rm : mloc; const float al = __builtin_amdgcn_exp2f(mloc - mnew);
                lsum *= al; mref = grow ? (mnew + cqt) : mref; mloc = mnew;
                if (h == 0) wsf[r] = al;
                asm volatile("s_waitcnt lgkmcnt(0)" ::: "memory");
#pragma unroll
                for (int g = 0; g < 4; ++g) { const f32x4 a4 = *(const LAS f32x4*)(wsf + 8 * g + 4 * h);
#pragma unroll
                    for (int cb = 0; cb < NCB; ++cb)
#pragma unroll
                        for (int e = 0; e < 4; ++e) o[cb][4 * g + e] *= a4[e]; }
            }
            float ps = 0.f; f32x2v ps2 = {0.f, 0.f};
#pragma unroll
            for (int i = 0; i < 16; i += 2) { const f32x2v ml = (f32x2v){mloc, mloc};
                const f32x2v a0 = (f32x2v){p0[i], p0[i + 1]} - ml, a1 = (f32x2v){p1[i], p1[i + 1]} - ml;
                f32x2v e0, e1; e0.x = __builtin_amdgcn_exp2f(a0.x); e0.y = __builtin_amdgcn_exp2f(a0.y); e1.x = __builtin_amdgcn_exp2f(a1.x); e1.y = __builtin_amdgcn_exp2f(a1.y);
                p0[i] = e0.x; p0[i + 1] = e0.y; p1[i] = e1.x; p1[i + 1] = e1.y; ps2 += e0 + e1; }
            ps = ps2.x + ps2.y;
            lsum += ps;
            bf16x8 pa[4];
            { u32x4 t0, t1, t2, t3;
              t0.x = pg8::cvt_pk_bf16(p0[0], p0[1]); t0.y = pg8::cvt_pk_bf16(p0[2], p0[3]); t0.z = pg8::cvt_pk_bf16(p0[4], p0[5]); t0.w = pg8::cvt_pk_bf16(p0[6], p0[7]);
              t1.x = pg8::cvt_pk_bf16(p0[8], p0[9]); t1.y = pg8::cvt_pk_bf16(p0[10], p0[11]); t1.z = pg8::cvt_pk_bf16(p0[12], p0[13]); t1.w = pg8::cvt_pk_bf16(p0[14], p0[15]);
              t2.x = pg8::cvt_pk_bf16(p1[0], p1[1]); t2.y = pg8::cvt_pk_bf16(p1[2], p1[3]); t2.z = pg8::cvt_pk_bf16(p1[4], p1[5]); t2.w = pg8::cvt_pk_bf16(p1[6], p1[7]);
              t3.x = pg8::cvt_pk_bf16(p1[8], p1[9]); t3.y = pg8::cvt_pk_bf16(p1[10], p1[11]); t3.z = pg8::cvt_pk_bf16(p1[12], p1[13]); t3.w = pg8::cvt_pk_bf16(p1[14], p1[15]);
              pa[0] = __builtin_bit_cast(bf16x8, t0); pa[1] = __builtin_bit_cast(bf16x8, t1); pa[2] = __builtin_bit_cast(bf16x8, t2); pa[3] = __builtin_bit_cast(bf16x8, t3); }
#pragma unroll
            for (int cb = 0; cb < NCB; ++cb) { s16x4 lo[4], hi[4];
#pragma unroll
                for (int ks = 0; ks < 4; ++ks) {
                    if (FOX && cb == 0) { lo[ks] = vlo0[ks]; hi[ks] = vhi0[ks]; }
                    else {
                    lo[ks] = __builtin_bit_cast(s16x4, __builtin_amdgcn_ds_read_tr16_b64_v4i16((LAS s16x4*)(b + vread0 + cb * 4096 + ks * 1024)));
                    hi[ks] = __builtin_bit_cast(s16x4, __builtin_amdgcn_ds_read_tr16_b64_v4i16((LAS s16x4*)(b + vread0 + cb * 4096 + ks * 1024 + 512))); } }
                __builtin_amdgcn_sched_barrier(0);
#pragma unroll
                for (int ks = 0; ks < 4; ++ks) { const bf16x8 vf = (bf16x8){lo[ks][0], lo[ks][1], lo[ks][2], lo[ks][3], hi[ks][0], hi[ks][1], hi[ks][2], hi[ks][3]};
                    o[cb] = __builtin_amdgcn_mfma_f32_32x32x16_bf16(pa[ks], vf, o[cb], 0, 0, 0); }
                __builtin_amdgcn_sched_barrier(0); }
        }
        if (t + 2 < NT) ATT_WAIT_TILE(); else asm volatile("s_waitcnt vmcnt(0)" ::: "memory");
        asm volatile("s_waitcnt lgkmcnt(0)" ::: "memory");
        __builtin_amdgcn_s_barrier();
        bc = (bc == 2) ? 0 : bc + 1; bn2 = (bn2 == 2) ? 0 : bn2 + 1;
    }
    lsum += __shfl_xor(lsum, 32);
    if (h == 0) wsf[r] = 1.0f / lsum;
    asm volatile("s_waitcnt lgkmcnt(0)" ::: "memory");
    bf16_t* Ow = O + (size_t)(q0 + 32 * w) * ldo;
#pragma unroll
    for (int i = 0; i < 16; ++i) { const int qr = crow(i, h); const float rl = wsf[qr];
#pragma unroll
        for (int cb = 0; cb < NCB; ++cb) Ow[(size_t)qr * ldo + 32 * cb + r] = (bf16_t)f2bf(o[cb][i] * rl); }
    asm volatile("s_waitcnt lgkmcnt(0)" ::: "memory");
#undef ATT_DMA
#undef ATT_WAIT_TILE
}
}


#define XB_TMO      128
#define XB_XCNT(j)  (256  + 64 * (j))
#define XB_XSUB(j)  (1280 + 64 * (j))
#define XB_XGEN(j)  (2304 + 64 * (j))
#define XB_TOP      3328
#define XB_TOPGEN   3392
#define XCD_BAR_WORDS 3456
#define XB_SPIN_CAP (1u << 18)
__device__ __forceinline__ unsigned xb_ld(unsigned* p)              { return __hip_atomic_load(p, __ATOMIC_RELAXED, __HIP_MEMORY_SCOPE_AGENT); }
__device__ __forceinline__ unsigned xb_add(unsigned* p, unsigned v) { return __hip_atomic_fetch_add(p, v, __ATOMIC_RELAXED, __HIP_MEMORY_SCOPE_AGENT); }
__device__ __forceinline__ unsigned xb_xcc_id() { return (unsigned)__builtin_amdgcn_s_getreg((3 << 11) | 20) & 0xFu; }
#define XB_SPIN(cond, bar) do { unsigned _sp = 0; while (cond) { __builtin_amdgcn_s_sleep(1); \
    if ((++_sp & 255u) == 0u) { if (xb_ld(&(bar)[XB_TMO])) break; if (_sp > XB_SPIN_CAP) { atomicAdd(&(bar)[XB_TMO], 1u); break; } } } } while (0)
struct XcdBarrier { unsigned* bar; unsigned x; volatile LAS unsigned* st; };
__device__ __forceinline__ XcdBarrier xcd_barrier_post(unsigned* bar, volatile LAS unsigned* st) {
    XcdBarrier b; b.bar = bar; b.x = xb_xcc_id(); b.st = st;
    if (threadIdx.x == 0) (void)xb_add(&bar[XB_XCNT(b.x)], 1u);
    return b;
}
__device__ __forceinline__ void xcd_barrier_complete(unsigned* bar, unsigned x, unsigned& nloc, unsigned& nx) {
    const unsigned G = gridDim.x * gridDim.y * gridDim.z;
    unsigned sum, cnt, mine, sp = 0u;
    for (;;) {
        sum = 0u; cnt = 0u; mine = 0u;
#pragma unroll
        for (unsigned j = 0; j < 16; ++j) { const unsigned c = xb_ld(&bar[XB_XCNT(j)]); sum += c; cnt += (c > 0u) ? 1u : 0u; mine = (j == x) ? c : mine; }
        if (sum == G) break;
        __builtin_amdgcn_s_sleep(1);
        if ((++sp & 255u) == 0u) { if (xb_ld(&bar[XB_TMO])) break; if (sp > XB_SPIN_CAP) { atomicAdd(&bar[XB_TMO], 1u); break; } }
    }
    nloc = mine > 0u ? mine : 1u; nx = cnt > 0u ? cnt : 1u;
}
__device__ __forceinline__ void xcd_barrier(unsigned* bar, unsigned x, volatile LAS unsigned* st) {
    asm volatile("s_waitcnt vmcnt(0)" ::: "memory");
    __syncthreads();
    if (threadIdx.x == 0) {
        __builtin_amdgcn_s_waitcnt(0);
        unsigned nloc = st[0], nx = st[1];
        if (nloc == 0u) { xcd_barrier_complete(bar, x, nloc, nx); st[0] = nloc; st[1] = nx; }
        const unsigned old = xb_add(&bar[XB_XSUB(x)], 1u);
        const unsigned gen = old / nloc;
        if (old + 1u == (gen + 1u) * nloc) {
            __builtin_amdgcn_fence(__ATOMIC_RELEASE, "agent");
            asm volatile("s_waitcnt vmcnt(0)" ::: "memory");
            const unsigned og = xb_add(&bar[XB_TOP], 1u);
            const unsigned tg = og / nx;
            if (og + 1u == (tg + 1u) * nx) xb_add(&bar[XB_TOPGEN], 1u);
            else XB_SPIN(xb_ld(&bar[XB_TOPGEN]) == tg, bar);
            __builtin_amdgcn_fence(__ATOMIC_ACQUIRE, "agent");
            xb_add(&bar[XB_XGEN(x)], 1u);
            asm volatile("s_waitcnt vmcnt(0)" ::: "memory");
        } else {
            XB_SPIN(xb_ld(&bar[XB_XGEN(x)]) == gen, bar);
            __builtin_amdgcn_fence(__ATOMIC_ACQUIRE, "agent");
            asm volatile("s_waitcnt vmcnt(0)" ::: "memory");
        }
    }
    __syncthreads();
}
constexpr int PTR_OFF = 139264, XB_ST_OFF = PTR_OFF + 512, CW_BAR = 1024;
__device__ __forceinline__ const void* ldptr(LAS unsigned char* lds, int k) {
    const LAS unsigned* p = (const LAS unsigned*)(lds + PTR_OFF) + 2 * k;
    const unsigned lo = __builtin_amdgcn_readfirstlane(p[0]), hi = __builtin_amdgcn_readfirstlane(p[1]);
    typedef __attribute__((address_space(1))) const void* gcptr_t;
    return (const void*)(gcptr_t)(((unsigned long long)hi << 32) | lo);
}
struct Args { const float* in[19]; float* out; unsigned char* ws; int ph_lo, ph_hi; };
constexpr int NPH = 13;

template <class MapF>
__device__ __forceinline__ void conv_item(const float* W, int K, int Nsrc, bf16_t* WT, LAS float* scr, int kb, int nb, int lane, const float* kscale, MapF mapf, bool nts = false) {
    const int k0 = 64 * kb, n0 = 64 * nb, r4 = lane >> 4, c4 = lane & 15; const int sc = mapf(n0 + 4 * c4);
    f32x4 v[16];
#pragma unroll
    for (int i = 0; i < 16; ++i) { const int kk = 4 * i + r4; v[i] = (f32x4){0.f, 0.f, 0.f, 0.f}; if (sc >= 0) v[i] = __builtin_nontemporal_load((const f32x4*)(W + (size_t)(k0 + kk) * Nsrc + sc)); }
#pragma unroll
    for (int i = 0; i < 16; ++i) { const int kk = 4 * i + r4; f32x4 t = v[i]; if (kscale) t = t * kscale[k0 + kk];
        LAS float* d = scr + kk * 65 + 4 * c4; d[0] = t[0]; d[1] = t[1]; d[2] = t[2]; d[3] = t[3]; }
    asm volatile("s_waitcnt lgkmcnt(0)" ::: "memory");
    const int c = lane & 7;
#pragma unroll
    for (int j = 0; j < 8; ++j) { const int n = (lane >> 3) + 8 * j; const LAS float* sp = scr + (8 * c) * 65 + n;
        u32x4 o; o.x = pk2(sp[0 * 65], sp[1 * 65]); o.y = pk2(sp[2 * 65], sp[3 * 65]); o.z = pk2(sp[4 * 65], sp[5 * 65]); o.w = pk2(sp[6 * 65], sp[7 * 65]);
        if (nts) __builtin_nontemporal_store(o, (u32x4*)(WT + (size_t)(n0 + n) * K + k0 + 8 * c)); else *(u32x4*)(WT + (size_t)(n0 + n) * K + k0 + 8 * c) = o; }
    asm volatile("s_waitcnt lgkmcnt(0)" ::: "memory");
}
__device__ __forceinline__ int rope_perm(int p) { return 4 * (p >> 3) + (p & 3) + 32 * ((p >> 2) & 1); }
__device__ __forceinline__ int map_win(int n) {
    if (n < PC_CQ) return n;
    if (n < PC_CKV) return 3088 + (n - PC_CQ);
    if (n < PC_F) return 3600 + (n - PC_CKV);
    if (n < PC_GF) { const int j = n - PC_F; if (j < 16) return 3072 + j; if (j >= 64 && j < 128) return 3856 + rope_perm(j - 64); return -1; }
    if (n < PC_GM) return 3920 + (n - PC_GF);
    return 5968 + (n - PC_GM);
}
__device__ __forceinline__ int map_wq(int n) { const int hh = n / 192, j = n % 192; return j < 128 ? n : hh * 192 + 128 + rope_perm(j - 128); }
__device__ __forceinline__ int map_id(int n) { return n; }

__global__ void __launch_bounds__(512, 2) fwd_kernel(Args a) {
    __builtin_assume(__builtin_amdgcn_workitem_id_y() == 0); __builtin_assume(__builtin_amdgcn_workitem_id_z() == 0);
    extern __shared__ __attribute__((aligned(16))) unsigned char lds_raw[];
    LAS unsigned char* lds = (LAS unsigned char*)lds_raw;
    const int tid = threadIdx.x, lane = tid & 63, wave = __builtin_amdgcn_readfirstlane(tid >> 6);
    const int G = gridDim.x, bx = blockIdx.x;
    const int gw = bx * 8 + wave, NGW = G * 8;
    LAS unsigned long long* ptab = (LAS unsigned long long*)(lds + PTR_OFF);
    if (tid == 0) {
        ptab[0] = (unsigned long long)a.in[0]; ptab[1] = (unsigned long long)a.in[1]; ptab[2] = (unsigned long long)a.in[2]; ptab[3] = (unsigned long long)a.in[3];
        ptab[4] = (unsigned long long)a.in[4]; ptab[5] = (unsigned long long)a.in[5]; ptab[6] = (unsigned long long)a.in[6]; ptab[7] = (unsigned long long)a.in[7];
        ptab[8] = (unsigned long long)a.in[8]; ptab[9] = (unsigned long long)a.in[9]; ptab[10] = (unsigned long long)a.in[10]; ptab[11] = (unsigned long long)a.in[11];
        ptab[12] = (unsigned long long)a.in[12]; ptab[13] = (unsigned long long)a.in[13]; ptab[14] = (unsigned long long)a.in[14]; ptab[15] = (unsigned long long)a.in[15];
        ptab[16] = (unsigned long long)a.in[16]; ptab[17] = (unsigned long long)a.in[17]; ptab[18] = (unsigned long long)a.in[18];
        ptab[19] = (unsigned long long)a.out; ptab[20] = (unsigned long long)a.ws;
    }
    if (tid == 1) { ((volatile LAS unsigned*)(lds + XB_ST_OFF))[0] = 0u; ((volatile LAS unsigned*)(lds + XB_ST_OFF))[1] = 0u; }
    __syncthreads();
    unsigned xb_x = 0;
    if (a.ph_hi - a.ph_lo > 1) { const XcdBarrier xb0 = xcd_barrier_post((unsigned*)a.ws + CW_BAR, (volatile LAS unsigned*)(lds + XB_ST_OFF)); xb_x = xb0.x; }
    if (a.ph_lo < 0) cg::this_grid().sync();
#define PTRF(k) ((const float*)ldptr(lds, (k)))
#define WSP(off) ((unsigned char*)ldptr(lds, 20) + (off))
#define OUTP ((float*)ldptr(lds, 19))
#define IN_x PTRF(0)
#define IN_cvec PTRF(1)
#define IN_w_ada PTRF(2)
#define IN_b_ada PTRF(3)
#define IN_w_in PTRF(4)
#define IN_b_forget PTRF(5)
#define IN_g_q PTRF(6)
#define IN_w_q PTRF(7)
#define IN_g_kv PTRF(8)
#define IN_w_kv PTRF(9)
#define IN_w_bf PTRF(10)
#define IN_w_bm PTRF(11)
#define IN_w_out PTRF(12)
#define IN_ln1_g PTRF(13)
#define IN_ln1_b PTRF(14)
#define IN_w_up PTRF(15)
#define IN_w_dn PTRF(16)
#define IN_ln2_g PTRF(17)
#define IN_ln2_b PTRF(18)
#define DECL_WS() asm volatile("" ::: "memory"); unsigned char* const ws = WSP(0); float* const out = OUTP; (void)out; \
    unsigned* const ctl = (unsigned*)(ws + WS_CTL); (void)ctl; \
    float* const mod = (float*)(ws + WS_MOD); float* const part = (float*)(ws + WS_PART); float* const cum = (float*)(ws + WS_CUM); (void)mod; (void)part; (void)cum; \
    float* const rstd_q = (float*)(ws + WS_RSTD); float* const rstd_kv = rstd_q + MTOK; (void)rstd_kv; \
    float* const cost = (float*)(ws + WS_ROPE); float* const sint = cost + SEQ * 32; (void)sint; \
    bf16_t* const krope = (bf16_t*)(ws + WS_KROPE); (void)krope; \
    bf16_t* const WinT = (bf16_t*)(ws + WS_WIN); bf16_t* const WupT = (bf16_t*)(ws + WS_WUP); bf16_t* const WdnT = (bf16_t*)(ws + WS_WDN); bf16_t* const WoutT = (bf16_t*)(ws + WS_WOUT); \
    bf16_t* const WbrT = (bf16_t*)(ws + WS_WBR); bf16_t* const WqT = (bf16_t*)(ws + WS_WQ); bf16_t* const WkvT = (bf16_t*)(ws + WS_WKV); \
    (void)WinT; (void)WupT; (void)WdnT; (void)WoutT; (void)WbrT; (void)WqT; (void)WkvT; \
    bf16_t* const proj = (bf16_t*)(ws + WS_PROJ); bf16_t* const hbuf = proj; bf16_t* const ubuf = (bf16_t*)(ws + WS_U); bf16_t* const ycat = ubuf; (void)hbuf; (void)ycat; \
    bf16_t* const qmla = (bf16_t*)(ws + WS_QMLA); bf16_t* const kvmla = (bf16_t*)(ws + WS_KVMLA); bf16_t* const merged = (bf16_t*)(ws + WS_MERGED); (void)qmla; (void)kvmla; (void)merged;

    const int lo = a.ph_lo, hi = a.ph_hi;
#ifndef PROBE_DUP
#define PROBE_DUP (-1)
#endif
#ifndef ATT_ONLY
#define ATT_ONLY 0
#endif
#define REPS(k) ((PROBE_DUP == (k)) ? 2 : 1)
#ifndef PHMASK
#define PHMASK 0x1fff
#endif
#define IN(k) (((PHMASK >> (k)) & 1) && lo <= (k) && (k) < hi)
#ifndef PROBE_SYNC
#define PROBE_SYNC 0
#endif
#define GRIDBAR() xcd_barrier((unsigned*)WSP(WS_CTL) + CW_BAR, xb_x, (volatile LAS unsigned*)(lds + XB_ST_OFF))
#define SEAM(k) do { if (IN(k) && IN((k) + 1)) { GRIDBAR(); if ((k) == 1) for (int q_ = 0; q_ < PROBE_SYNC; ++q_) GRIDBAR(); } } while (0)

    if (IN(0)) for (int rep = 0; rep < REPS(0); ++rep) { DECL_WS();
        const float* const wada_p = IN_w_ada; const float* const c_p = IN_cvec;
        LAS float* scr = (LAS float*)(lds + wave * 16640);
        constexpr int I_ADA = 48 * KC_ADA, I_IN = 32 * 128, I_UP = 32 * 128, I_DN = 128 * 32, I_OUT = 32 * 32, I_BR = 16 * 32, I_Q = 8 * 24, I_KV = 4 * 32;
        constexpr int NITEMS = I_ADA + I_IN + I_UP + I_DN + I_OUT + 2 * I_BR + I_Q + I_KV;
        for (int it = gw; it < NITEMS; it += NGW) {
            int r = it;
            if (r < I_ADA) {
                const int cb = r % 48, kc = r / 48, col = cb * 256 + lane * 4;
                f32x4 s0 = {0.f, 0.f, 0.f, 0.f}, s1 = {0.f, 0.f, 0.f, 0.f};
                const int kbeg = kc * (DMODEL / KC_ADA);
#pragma unroll 16
                for (int k = kbeg; k < kbeg + DMODEL / KC_ADA; ++k) {
                    const f32x4 wv = __builtin_nontemporal_load((const f32x4*)(wada_p + (size_t)k * NADA + col));
                    const float c0 = c_p[k], c1 = c_p[DMODEL + k];
                    const float a0 = c0 * sigmoidf_(c0), a1 = c1 * sigmoidf_(c1);
                    s0 += wv * a0; s1 += wv * a1;
                }
                *(f32x4*)(part + (size_t)(kc * 2 + 0) * NADA + col) = s0; *(f32x4*)(part + (size_t)(kc * 2 + 1) * NADA + col) = s1;
                continue;
            }
            r -= I_ADA;
            if (r < I_IN) { conv_item(IN_w_in, 2048, DIN, WinT, scr, r / 128, r % 128, lane, nullptr, map_win); continue; } r -= I_IN;
            if (r < I_UP) { conv_item(IN_w_up, 2048, DFF, WupT, scr, r / 128, r % 128, lane, nullptr, map_id, true); continue; } r -= I_UP;
            if (r < I_DN) { conv_item(IN_w_dn, 8192, DMODEL, WdnT, scr, r / 32, r % 32, lane, nullptr, map_id, true); continue; } r -= I_DN;
            if (r < I_OUT) { conv_item(IN_w_out, 2048, DMODEL, WoutT, scr, r / 32, r % 32, lane, nullptr, map_id, true); continue; } r -= I_OUT;
            if (r < I_BR) { conv_item(IN_w_bf, 1024, DMODEL, WbrT, scr, r / 32, r % 32, lane, nullptr, map_id, true); continue; } r -= I_BR;
            if (r < I_BR) { conv_item(IN_w_bm, 1024, DMODEL, WbrT + (size_t)2048 * 1024, scr, r / 32, r % 32, lane, nullptr, map_id, true); continue; } r -= I_BR;
            if (r < I_Q) { conv_item(IN_w_q, 512, QW, WqT, scr, r / 24, r % 24, lane, IN_g_q, map_wq); continue; } r -= I_Q;
            conv_item(IN_w_kv, 256, KVW, WkvT, scr, r / 32, r % 32, lane, IN_g_kv, map_id);
        }
        for (int e = bx * 512 + tid; e < SEQ * 32; e += G * 512) {
            const int pos = e >> 5, i = e & 31;
            const float inv = powf(10000.0f, -(float)(2 * i) / 64.0f);
            const float ang = (float)pos * inv;
            const double ad = (double)ang; const double n = rint(ad * 0.15915494309189535); const float rr = (float)(ad - n * 6.283185307179586);
            cost[e] = cosf(rr); sint[e] = sinf(rr);
        }
    }
    SEAM(0);
    if (IN(1)) for (int rep = 0; rep < REPS(1); ++rep) { DECL_WS();
        const float* const bada_p = IN_b_ada;
        for (int e = bx * 512 + tid; e < 2 * NADA; e += G * 512) { const int b = e / NADA, n = e % NADA; float s = bada_p[n];
#pragma unroll
            for (int kc = 0; kc < KC_ADA; ++kc) s += part[(size_t)(kc * 2 + b) * NADA + n];
            mod[e] = s; }
    }
    SEAM(1);
    if (IN(2)) for (int rep = 0; rep < REPS(2); ++rep) { DECL_WS();
        const float* const x_p = IN_x;
        for (int m = 4 * gw; m < MTOK; m += 4 * NGW) {
            const float* md = mod + (size_t)(m >> 12) * NADA; const f32x4* xr = (const f32x4*)(x_p + (size_t)m * DMODEL) + lane;
            f32x4 vr[4][8];
#pragma unroll
            for (int q = 0; q < 4; ++q)
#pragma unroll
                for (int j = 0; j < 8; ++j) vr[q][j] = __builtin_nontemporal_load(xr + 512 * q + 64 * j);
            u32x2* o8 = (u32x2*)(ubuf + (size_t)m * DMODEL) + lane;
            f32x4 shv[8], scv[8];
#pragma unroll
            for (int j = 0; j < 8; ++j) { const int col = 4 * lane + 256 * j; shv[j] = *(const f32x4*)(md + col); scv[j] = *(const f32x4*)(md + DMODEL + col) + 1.0f; }
#pragma unroll
            for (int q = 0; q < 4; ++q)
#pragma unroll
                for (int j = 0; j < 8; ++j) { const f32x4 uu = vr[q][j] * scv[j] + shv[j]; u32x2 wv; wv.x = pg8::cvt_pk_bf16(uu[0], uu[1]); wv.y = pg8::cvt_pk_bf16(uu[2], uu[3]); o8[512 * q + 64 * j] = wv; } }
    }
    SEAM(2);
    if (IN(3)) for (int rep = 0; rep < REPS(3); ++rep) { DECL_WS();
        pg8::Gemm g{ubuf, WinT, MTOK, NPROJ, DMODEL, DMODEL}; pg8::StaticOrder S; S.init(MTOK, NPROJ, G, bx);
        pg8::EpiBf16<0> E{proj, NPROJ, 4, C2F, nullptr};
        pg8::gemm_phase<pg8::EpiBf16<0>, pg8::StaticOrder>(lds, g, S, E);
    }
    SEAM(3);
    if (IN(4)) for (int rep = 0; rep < REPS(4); ++rep) { DECL_WS();
        if (gw < 128) {
            const int b = gw >> 6, ch = gw & 63; const float* const bfp = IN_b_forget; float* const totp = (float*)(ws + WS_TOT);
            const bf16_t* fp = proj + (size_t)(b * SEQ + ch * 64 + lane) * NPROJ + PC_F;
            const u32x4 f0 = *(const u32x4*)fp, f1 = *(const u32x4*)(fp + 8);
            float fz[16] = {bflo(f0.x), bfhi(f0.x), bflo(f0.y), bfhi(f0.y), bflo(f0.z), bfhi(f0.z), bflo(f0.w), bfhi(f0.w),
                            bflo(f1.x), bfhi(f1.x), bflo(f1.y), bfhi(f1.y), bflo(f1.z), bfhi(f1.z), bflo(f1.w), bfhi(f1.w)};
#pragma unroll
            for (int hh = 0; hh < 16; ++hh) { const float z = fz[hh] + bfp[hh]; float incl = (fminf(z, 0.f) - log1pf(__expf(-fabsf(z)))) * LOG2E;
#pragma unroll
                for (int o = 1; o < 64; o <<= 1) { const float t = __shfl_up(incl, o); if (lane >= o) incl += t; }
                cum[(size_t)(b * 16 + hh) * SEQ + ch * 64 + lane] = incl; ((float*)(ws + WS_NCUM))[(size_t)(b * 16 + hh) * SEQ + ch * 64 + lane] = -incl;
                if (lane == 63) totp[(b * 16 + hh) * 64 + ch] = incl; }
        }
        for (int m = gw; m < MTOK; m += NGW) {
            const bf16_t* pr = proj + (size_t)m * NPROJ;
            { const u32x4 v = *(const u32x4*)(pr + PC_CQ + lane * 8); float s = 0.f;
              s += bflo(v.x) * bflo(v.x) + bfhi(v.x) * bfhi(v.x) + bflo(v.y) * bflo(v.y) + bfhi(v.y) * bfhi(v.y) + bflo(v.z) * bflo(v.z) + bfhi(v.z) * bfhi(v.z) + bflo(v.w) * bflo(v.w) + bfhi(v.w) * bfhi(v.w);
              s = wave_sum(s); if (lane == 0) rstd_q[m] = 1.0f / sqrtf(s * (1.0f / 512.0f) + RMS_EPS); }
            { float s = 0.f; if (lane < 32) { const u32x4 v = *(const u32x4*)(pr + PC_CKV + lane * 8);
              s += bflo(v.x) * bflo(v.x) + bfhi(v.x) * bfhi(v.x) + bflo(v.y) * bflo(v.y) + bfhi(v.y) * bfhi(v.y) + bflo(v.z) * bflo(v.z) + bfhi(v.z) * bfhi(v.z) + bflo(v.w) * bflo(v.w) + bfhi(v.w) * bfhi(v.w); }
              s = wave_sum(s); if (lane == 0) rstd_kv[m] = 1.0f / sqrtf(s * (1.0f / 256.0f) + RMS_EPS); }
            if (lane < 8) { const u32x4 v = *(const u32x4*)(pr + PC_KR + lane * 8); const int pos = m & (SEQ - 1), i0 = lane * 4;
                const f32x4 cs = *(const f32x4*)(cost + pos * 32 + i0), sn = *(const f32x4*)(sint + pos * 32 + i0);
                const f32x4 x1 = {bflo(v.x), bfhi(v.x), bflo(v.y), bfhi(v.y)}, x2 = {bflo(v.z), bfhi(v.z), bflo(v.w), bfhi(v.w)};
                const f32x4 o1 = x1 * cs - x2 * sn, o2 = x1 * sn + x2 * cs;
                u32x4 wv; wv.x = pk2(o1[0], o1[1]); wv.y = pk2(o1[2], o1[3]); wv.z = pk2(o2[0], o2[1]); wv.w = pk2(o2[2], o2[3]);
                *(u32x4*)(krope + (size_t)m * 64 + lane * 8) = wv; }
        }
    }
    SEAM(4);
    if (IN(5)) for (int rep = 0; rep < REPS(5); ++rep) { DECL_WS();
        { pg8::Gemm g{proj + PC_CKV, WkvT, MTOK, KVW, 256, NPROJ}; pg8::StaticOrder S; S.init(MTOK, KVW, G, bx);
          pg8::EpiBf16<0> E{kvmla, KVW, 0, 1.f, rstd_kv};
          pg8::gemm_phase<pg8::EpiBf16<0>, pg8::StaticOrder>(lds, g, S, E); }
        { pg8::Gemm g{proj + PC_CQ, WqT, MTOK, QW, 512, NPROJ}; pg8::StaticOrder S; S.init(MTOK, QW, G, bx);
          pg8::EpiQup E{qmla, rstd_q, cost, sint};
          pg8::gemm_phase<pg8::EpiQup, pg8::StaticOrder>(lds, g, S, E); }
    }
    SEAM(5);
    if (IN(6)) { DECL_WS(); constexpr int rep = 0;
        LAS unsigned* qw = (LAS unsigned*)(lds + att::Q_OFF);
        for (;;) {
            if (tid == 0) *qw = atomicAdd(ctl + 64 * rep, 1u);
            __syncthreads();
            const unsigned idx = *qw;
            __syncthreads();
            if (idx >= 768u) break;
            const int level = idx / 48, rr = idx % 48, qb = 15 - level;
            if (ATT_ONLY != 2 && (ATT_ONLY == 1 || rr < 16)) { const int b = rr >> 3, hh = rr & 7; const size_t rb = (size_t)b * SEQ;
                att::attn_unit<192, 128, false>(qmla + rb * QW + hh * 192, QW, kvmla + rb * KVW + hh * 256, KVW, krope + rb * 64, 64,
                                                kvmla + rb * KVW + hh * 256 + 128, KVW, ycat + rb * DMODEL + 1024 + hh * 128, DMODEL, nullptr, nullptr, nullptr, qb, lds);
            } else { const int bh = rr - 16, b = bh >> 4, hh = bh & 15; const size_t rb = (size_t)b * SEQ;
                att::attn_unit<64, 64, true>(proj + rb * NPROJ + PC_Q + hh * 64, NPROJ, proj + rb * NPROJ + PC_K + hh * 64, NPROJ, nullptr, 0,
                                             proj + rb * NPROJ + PC_V + hh * 64, NPROJ, ycat + rb * DMODEL + hh * 64, DMODEL, cum + (size_t)bh * SEQ, (const float*)(ws + WS_NCUM) + (size_t)bh * SEQ, (const float*)(ws + WS_TOT) + bh * 64, qb, lds);
            }
        }
    }
#if PROBE_DUP == 6
    if (IN(6)) { DECL_WS(); constexpr int rep = 1;
        LAS unsigned* qw = (LAS unsigned*)(lds + att::Q_OFF);
        for (;;) {
            if (tid == 0) *qw = atomicAdd(ctl + 64 * rep, 1u);
            __syncthreads();
            const unsigned idx = *qw;
            __syncthreads();
            if (idx >= 768u) break;
            const int level = idx / 48, rr = idx % 48, qb = 15 - level;
            if (ATT_ONLY != 2 && (ATT_ONLY == 1 || rr < 16)) { const int b = rr >> 3, hh = rr & 7; const size_t rb = (size_t)b * SEQ;
                att::attn_unit<192, 128, false>(qmla + rb * QW + hh * 192, QW, kvmla + rb * KVW + hh * 256, KVW, krope + rb * 64, 64,
                                                kvmla + rb * KVW + hh * 256 + 128, KVW, ycat + rb * DMODEL + 1024 + hh * 128, DMODEL, nullptr, nullptr, nullptr, qb, lds);
            } else { const int bh = rr - 16, b = bh >> 4, hh = bh & 15; const size_t rb = (size_t)b * SEQ;
                att::attn_unit<64, 64, true>(proj + rb * NPROJ + PC_Q + hh * 64, NPROJ, proj + rb * NPROJ + PC_K + hh * 64, NPROJ, nullptr, 0,
                                             proj + rb * NPROJ + PC_V + hh * 64, NPROJ, ycat + rb * DMODEL + hh * 64, DMODEL, cum + (size_t)bh * SEQ, (const float*)(ws + WS_NCUM) + (size_t)bh * SEQ, (const float*)(ws + WS_TOT) + bh * 64, qb, lds);
            }
        }
    }
#endif
    SEAM(6);
    if (IN(7)) for (int rep = 0; rep < REPS(7); ++rep) { DECL_WS();
        pg8::Gemm g{ycat, WbrT, MTOK, DMODEL, 1024, DMODEL}; pg8::BranchOrder S; S.init(MTOK, DMODEL, G, bx);
        pg8::EpiBranch E{merged, proj};
        pg8::gemm_phase<pg8::EpiBranch, pg8::BranchOrder>(lds, g, S, E);
    }
    SEAM(7);
    if (IN(8)) for (int rep = 0; rep < REPS(8); ++rep) { DECL_WS();
        pg8::Gemm g{merged, WoutT, MTOK, DMODEL, DMODEL, DMODEL}; pg8::StaticOrder S; S.init(MTOK, DMODEL, G, bx);
        pg8::EpiResid E{IN_x, out, mod + 2 * DMODEL};
        pg8::gemm_phase<pg8::EpiResid, pg8::StaticOrder>(lds, g, S, E);
    }
    SEAM(8);
    if (IN(9)) for (int rep = 0; rep < REPS(9); ++rep) { DECL_WS();
        const float* const lng_p = IN_ln1_g; const float* const lnb_p = IN_ln1_b;
        for (int m = 2 * gw; m < MTOK; m += 2 * NGW) {
            const float* md = mod + (size_t)(m >> 12) * NADA; f32x4* xr = (f32x4*)(out + (size_t)m * DMODEL) + lane;
            f32x4 va[8], vb[8]; float sa = 0.f, sb = 0.f;
#pragma unroll
            for (int j = 0; j < 8; ++j) { va[j] = __builtin_nontemporal_load(xr + 64 * j); vb[j] = __builtin_nontemporal_load(xr + 512 + 64 * j); }
#pragma unroll
            for (int j = 0; j < 8; ++j) { sa += (va[j][0] + va[j][1]) + (va[j][2] + va[j][3]); sb += (vb[j][0] + vb[j][1]) + (vb[j][2] + vb[j][3]); }
            const float mean_a = wave_sum(sa) * (1.0f / DMODEL), mean_b = wave_sum(sb) * (1.0f / DMODEL); float qa = 0.f, qb_ = 0.f;
#pragma unroll
            for (int j = 0; j < 8; ++j) { va[j] = va[j] - mean_a; vb[j] = vb[j] - mean_b;
                qa += (va[j][0] * va[j][0] + va[j][1] * va[j][1]) + (va[j][2] * va[j][2] + va[j][3] * va[j][3]);
                qb_ += (vb[j][0] * vb[j][0] + vb[j][1] * vb[j][1]) + (vb[j][2] * vb[j][2] + vb[j][3] * vb[j][3]); }
            const float rstd_a = 1.0f / sqrtf(wave_sum(qa) * (1.0f / DMODEL) + LN_EPS), rstd_b = 1.0f / sqrtf(wave_sum(qb_) * (1.0f / DMODEL) + LN_EPS);
            u32x2* o8 = (u32x2*)(ubuf + (size_t)m * DMODEL) + lane;
            f32x4 ggv[8], bbv[8], shv[8], scv[8];
#pragma unroll
            for (int j = 0; j < 8; ++j) { const int col = 4 * lane + 256 * j; ggv[j] = *(const f32x4*)(lng_p + col); bbv[j] = *(const f32x4*)(lnb_p + col);
                shv[j] = *(const f32x4*)(md + 3 * DMODEL + col); scv[j] = *(const f32x4*)(md + 4 * DMODEL + col); }
#pragma unroll
            for (int j = 0; j < 8; ++j) { const f32x4 gg = ggv[j], bb = bbv[j];
                const f32x4 ya = va[j] * rstd_a * gg + bb, yb = vb[j] * rstd_b * gg + bb; __builtin_nontemporal_store(ya, xr + 64 * j); __builtin_nontemporal_store(yb, xr + 512 + 64 * j);
                const f32x4 sh = shv[j], sc = scv[j] + 1.0f;
                const f32x4 ua = ya * sc + sh, ub = yb * sc + sh; u32x2 wa, wb;
                wa.x = pg8::cvt_pk_bf16(ua[0], ua[1]); wa.y = pg8::cvt_pk_bf16(ua[2], ua[3]); wb.x = pg8::cvt_pk_bf16(ub[0], ub[1]); wb.y = pg8::cvt_pk_bf16(ub[2], ub[3]);
                o8[64 * j] = wa; o8[512 + 64 * j] = wb; } }
    }
    SEAM(9);
    if (IN(10)) for (int rep = 0; rep < REPS(10); ++rep) { DECL_WS();
        pg8::Gemm g{ubuf, WupT, MTOK, DFF, DMODEL, DMODEL}; pg8::StaticOrder S; S.init(MTOK, DFF, G, bx);
        pg8::EpiBf16<1> E{hbuf, DFF, 0, 1.f, nullptr};
        pg8::gemm_phase<pg8::EpiBf16<1>, pg8::StaticOrder>(lds, g, S, E);
    }
    SEAM(10);
    if (IN(11)) for (int rep = 0; rep < REPS(11); ++rep) { DECL_WS();
        pg8::Gemm g{hbuf, WdnT, MTOK, DMODEL, DFF, DFF}; pg8::StaticOrder S; S.init(MTOK, DMODEL, G, bx);
        pg8::EpiResid E{out, out, mod + 5 * DMODEL};
        pg8::gemm_phase<pg8::EpiResid, pg8::StaticOrder>(lds, g, S, E);
    }
    SEAM(11);
    if (IN(12)) for (int rep = 0; rep < REPS(12); ++rep) { DECL_WS();
        const float* const lng_p = IN_ln2_g; const float* const lnb_p = IN_ln2_b;
        for (int m = 4 * gw; m < MTOK; m += 4 * NGW) { f32x4* xr = (f32x4*)(out + (size_t)m * DMODEL) + lane;
            f32x4 vr[4][8]; float sm[4], qq[4], rs[4];
#pragma unroll
            for (int q = 0; q < 4; ++q)
#pragma unroll
                for (int j = 0; j < 8; ++j) vr[q][j] = __builtin_nontemporal_load(xr + 512 * q + 64 * j);
            f32x4 ggv[8], bbv[8];
#pragma unroll
            for (int j = 0; j < 8; ++j) { const int col = 4 * lane + 256 * j; ggv[j] = *(const f32x4*)(lng_p + col); bbv[j] = *(const f32x4*)(lnb_p + col); }
#pragma unroll
            for (int q = 0; q < 4; ++q) { float s_ = 0.f;
#pragma unroll
                for (int j = 0; j < 8; ++j) s_ += (vr[q][j][0] + vr[q][j][1]) + (vr[q][j][2] + vr[q][j][3]);
                sm[q] = wave_sum(s_) * (1.0f / DMODEL); }
#pragma unroll
            for (int q = 0; q < 4; ++q) { float s2 = 0.f;
#pragma unroll
                for (int j = 0; j < 8; ++j) { vr[q][j] = vr[q][j] - sm[q]; s2 += (vr[q][j][0] * vr[q][j][0] + vr[q][j][1] * vr[q][j][1]) + (vr[q][j][2] * vr[q][j][2] + vr[q][j][3] * vr[q][j][3]); }
                qq[q] = wave_sum(s2); rs[q] = 1.0f / sqrtf(qq[q] * (1.0f / DMODEL) + LN_EPS); }
#pragma unroll
            for (int q = 0; q < 4; ++q)
#pragma unroll
                for (int j = 0; j < 8; ++j) __builtin_nontemporal_store(vr[q][j] * rs[q] * ggv[j] + bbv[j], xr + 512 * q + 64 * j); }
    }
#undef IN
#undef SEAM
#undef IN_x
#undef IN_cvec
#undef IN_w_ada
#undef IN_b_ada
#undef IN_w_in
#undef IN_b_forget
#undef IN_g_q
#undef IN_w_q
#undef IN_g_kv
#undef IN_w_kv
#undef IN_w_bf
#undef IN_w_bm
#undef IN_w_out
#undef IN_ln1_g
#undef IN_ln1_b
#undef IN_w_up
#undef IN_w_dn
#undef IN_ln2_g
#undef IN_ln2_b
}

extern "C" void kernel_launch(void* const* d_in, const int* in_sizes, int n_in, void* d_out, int out_size, void* d_ws, size_t ws_size, hipStream_t stream) {
    static int grid = 0;
    if (grid == 0) {
        if (n_in != 19 || out_size != MTOK * DMODEL || ws_size < WS_END) { fprintf(stderr, "kernel_launch: unexpected problem (n_in %d, out %d, ws %zu)\n", n_in, out_size, ws_size); grid = -1; return; }
        int dev = 0, cus = 0, per_cu = 0;
        if (hipGetDevice(&dev) != hipSuccess || hipDeviceGetAttribute(&cus, hipDeviceAttributeMultiprocessorCount, dev) != hipSuccess) { grid = -1; return; }
        if (hipFuncSetAttribute((const void*)fwd_kernel, hipFuncAttributeMaxDynamicSharedMemorySize, LDS_BYTES) != hipSuccess) { fprintf(stderr, "kernel_launch: hipFuncSetAttribute failed\n"); grid = -1; return; }
        if (hipOccupancyMaxActiveBlocksPerMultiprocessor(&per_cu, (const void*)fwd_kernel, 512, LDS_BYTES) != hipSuccess || per_cu < 1) { fprintf(stderr, "kernel_launch: occupancy query gave %d\n", per_cu); per_cu = 1; }
        (void)hipGetLastError();
        grid = cus * 1;
    }
    if (grid < 0) return;
    (void)hipMemsetAsync((char*)d_ws + WS_CTL, 0, 65536, stream);
    Args a{};
    for (int i = 0; i < 19; ++i) a.in[i] = (const float*)d_in[i];
    a.out = (float*)d_out; a.ws = (unsigned char*)d_ws;
#if MK_N_LAUNCHES == 1
    a.ph_lo = 0; a.ph_hi = NPH;
    void* args[] = {&a};
    hipError_t e = hipLaunchCooperativeKernel((const void*)fwd_kernel, dim3(grid), dim3(512), args, LDS_BYTES, stream);
    if (e != hipSuccess) fprintf(stderr, "kernel_launch: cooperative launch failed: %s (grid %d)\n", hipGetErrorString(e), grid);
#else
    for (int p = 0; p < NPH; ++p) { a.ph_lo = p; a.ph_hi = p + 1; hipLaunchKernelGGL(fwd_kernel, dim3(grid), dim3(512), LDS_BYTES, stream, a); }
#endif
}
```
